# Optimizing an MI355X kernel written in HIP

```python
import math
import jax, jax.numpy as jnp
from jax import lax
import numpy as np


D_MODEL = 1024
BATCH = 8
SEQ = 4096
DEPTH = 2
DEC_BATCH = 2
DEC_SEQ = 16384
PAST_LEN = 128

D_MIX = D_MODEL
HY_W = D_MIX // 4
HG_W = D_MIX // 2
RG_W = D_MIX - HY_W - HG_W
HY_SHORT = 3
HY_EMB = 33
HY_BANDS = (HY_EMB - 1) // 2
HY_FFN = 64
HY_FAST_DECAY = 0.3
HY_SLOW_DECAY = 1.5
HY_TARGET = 1e-2
HG_HEADS = 4
HG_DK = HG_W // HG_HEADS
HG_DV = HG_W // HG_HEADS
HG_CHUNK = 64
RG_HEADS = 4
RG_HD = RG_W // RG_HEADS
RG_CONV = 4
RG_C = 8.0
D_FF = -(-8 * D_MODEL // (3 * 256)) * 256
HY_IN = 3 * HY_W
HG_IN = 5 * HG_W
RG_IN = 2 * RG_W
D_IN = HY_IN + HG_IN + RG_IN
EPS = 1e-6

kernel_name = 'hymba_style_hyena_hgrn2_rglru_encoder'


def rmsnorm(x, w):
    xf = x.astype(jnp.float32)
    y = xf * lax.rsqrt(jnp.mean(xf * xf, axis=-1, keepdims=True) + EPS)
    return (y * w.astype(jnp.float32)).astype(x.dtype)


def dwconv(x, w, b, left):
    K = w.shape[0]
    L = x.shape[1]
    xp = jnp.pad(x, ((0, 0), (left, K - 1 - left), (0, 0)))
    y = b
    for k in range(K):
        y = y + xp[:, k:k + L] * w[k]
    return y


def hyena_filter(L, w1, b1, w2, b2, w3, b3, w4, freq):
    f32 = jnp.float32
    t = jnp.linspace(0.0, 1.0, L, dtype=f32)[:, None]
    n = jnp.arange(L, dtype=f32)[:, None]
    fb = jnp.linspace(1e-4, HY_BANDS - 1, HY_BANDS, dtype=f32)[None, :]
    ang = fb * n * (2.0 * math.pi / L)
    z = jnp.concatenate([t, jnp.cos(ang), -jnp.sin(ang)], axis=-1)
    fr = freq.astype(f32)
    h = jnp.sin(fr * (z @ w1.astype(f32) + b1.astype(f32)))
    h = jnp.sin(fr * (h @ w2.astype(f32) + b2.astype(f32)))
    h = jnp.sin(fr * (h @ w3.astype(f32) + b3.astype(f32)))
    h = h @ w4.astype(f32)
    deltas = jnp.abs(jnp.linspace(math.log(HY_TARGET) / HY_SLOW_DECAY,
                                  math.log(HY_TARGET) / HY_FAST_DECAY, HY_W, dtype=f32))
    decay = jnp.exp(-t * deltas)
    return h * jnp.concatenate([decay, decay], axis=-1)


def hyena_mixer(u, conv_w, conv_b, w1, b1, w2, b2, w3, b3, w4, freq, bias):
    B, L, _ = u.shape
    uc = dwconv(u, conv_w, conv_b, (HY_SHORT - 1) // 2)
    x0, x1, v = jnp.split(uc, 3, axis=-1)
    v = (v * x1).astype(jnp.float32)
    k = hyena_filter(L, w1, b1, w2, b2, w3, b3, w4, freq)
    kf, kb = k[:, :HY_W], k[:, HY_W:]
    kc = jnp.concatenate([kf, jnp.zeros((1, HY_W), jnp.float32), kb[:0:-1]], axis=0)
    spec = jnp.fft.rfft(v, n=2 * L, axis=1) * jnp.fft.rfft(kc, n=2 * L, axis=0)[None]
    y = jnp.fft.irfft(spec, n=2 * L, axis=1)[:, :L]
    y = y + v * bias.astype(jnp.float32)
    return y * x0.astype(jnp.float32)


def hgrn2_scan(q, k, v, logf):
    B, L, H, Dk = q.shape
    Dv = v.shape[-1]
    C = HG_CHUNK
    n = L // C

    def chunks(a):
        return a.reshape(B, n, C, H, a.shape[-1]).transpose(1, 0, 3, 2, 4)

    causal = jnp.tril(jnp.ones((C, C), bool))[:, :, None]

    def step(S, inp):
        qc, kc, vc, gc = inp
        b = jnp.cumsum(gc, axis=2)
        inter = jnp.einsum('bhtk,bhkv->bhtv', qc * jnp.exp(b), S)
        diff = b[:, :, :, None, :] - b[:, :, None, :, :]
        w = jnp.where(causal, jnp.exp(jnp.where(causal, diff, 0.0)), 0.0)
        A = jnp.einsum('bhtk,bhtsk,bhsk->bhts', qc, w, kc)
        o = inter + jnp.einsum('bhts,bhsv->bhtv', A, vc)
        bl = b[:, :, -1:, :]
        S = jnp.exp(bl[:, :, 0, :])[..., None] * S + jnp.einsum('bhsk,bhsv->bhkv', kc * jnp.exp(bl - b), vc)
        return S, o

    S0 = jnp.zeros((B, H, Dk, Dv), jnp.float32)
    _, o = lax.scan(step, S0, (chunks(q), chunks(k), chunks(v), chunks(logf)))
    return o.transpose(1, 0, 3, 2, 4).reshape(B, L, H, Dv)


def hgrn2_mixer(u, lb_f, lb_b):
    B, L, _ = u.shape
    q, i, zf, zb, g = jnp.split(u, 5, axis=-1)

    def heads(a):
        return a.astype(jnp.float32).reshape(B, L, HG_HEADS, -1)

    q, v = heads(q), heads(i)

    def direction(z, lb, qd, vd):
        z = heads(z)
        lb = lb.astype(jnp.float32).reshape(HG_HEADS, HG_DK)
        logf = jax.nn.log_sigmoid(z) + jnp.log1p(lb * jnp.exp(-z))
        kk = (1.0 - lb) * jax.nn.sigmoid(-z)
        return hgrn2_scan(qd, kk, vd, logf)

    o_f = direction(zf, lb_f, q, v)
    o_b = jnp.flip(direction(jnp.flip(zb, 1), lb_b, jnp.flip(q, 1), jnp.flip(v, 1)), 1)
    return o_f + o_b, g


def lru_combine(e1, e2):
    a1, b1 = e1
    a2, b2 = e2
    return (a1 * a2, a2 * b1 + b2)


def rglru_mixer(u, conv_w, conv_b, wa, ba, wx, bx, lam):
    B, L, _ = u.shape
    xr_in, gate = jnp.split(u, 2, axis=-1)
    xr = dwconv(xr_in, conv_w, conv_b, RG_CONV // 2).astype(jnp.float32)

    def blockdiag(a, w):
        return jnp.einsum('blhi,hij->blhj', a.reshape(B, L, RG_HEADS, RG_HD),
                          w.astype(jnp.float32)).reshape(B, L, RG_W)

    def direction(xd, d):
        r = jax.nn.sigmoid(blockdiag(xd, wa[d]) + ba[d].astype(jnp.float32))
        ig = jax.nn.sigmoid(blockdiag(xd, wx[d]) + bx[d].astype(jnp.float32))
        log_a = -RG_C * r * jax.nn.softplus(-lam[d].astype(jnp.float32))
        a = jnp.exp(log_a)
        bterm = jnp.sqrt(-jnp.expm1(2.0 * log_a)) * (ig * xd)
        _, h = lax.associative_scan(lru_combine, (a, bterm), axis=1)
        return h

    h = direction(xr, 0) + jnp.flip(direction(jnp.flip(xr, 1), 1), 1)
    return h * jax.nn.gelu(gate.astype(jnp.float32))


def token_mixer(h, l, lb_f, lb_b, p):
    B, L, _ = h.shape
    u = h @ p['w_in'][l]
    u_hy = u[..., :HY_IN]
    u_hg = u[..., HY_IN:HY_IN + HG_IN]
    u_rg = u[..., HY_IN + HG_IN:]
    y_hy = hyena_mixer(u_hy, p['hy_conv_w'][l], p['hy_conv_b'][l], p['hy_w1'][l], p['hy_b1'][l],
                       p['hy_w2'][l], p['hy_b2'][l], p['hy_w3'][l], p['hy_b3'][l], p['hy_w4'][l],
                       p['hy_freq'][l], p['hy_bias'][l])
    o_hg, g_hg = hgrn2_mixer(u_hg, lb_f, lb_b)
    y_rg = rglru_mixer(u_rg, p['rg_conv_w'][l], p['rg_conv_b'][l], p['rg_wa'][l], p['rg_ba'][l],
                       p['rg_wx'][l], p['rg_bx'][l], p['rg_lambda'][l])
    gain = p['out_norm_w'][l]
    y_hy = rmsnorm(y_hy, gain[:HY_W])
    y_hg = rmsnorm(o_hg, gain[HY_W:HY_W + HG_W].reshape(HG_HEADS, HG_DV)).reshape(B, L, HG_W)
    y_hg = y_hg * jax.nn.silu(g_hg.astype(jnp.float32))
    y_rg = rmsnorm(y_rg, gain[HY_W + HG_W:])
    y = jnp.concatenate([y_hy, y_hg, y_rg], axis=-1).astype(h.dtype)
    return y @ p['w_out'][l]


def swiglu(h, wg, wu, wd):
    return (jax.nn.silu(h @ wg) * (h @ wu)) @ wd


def trunk(x, c, p):
    lb_all = jax.nn.softmax(p['hg_lb_logits'].astype(jnp.float32), axis=1)
    lb_all = jnp.cumsum(lb_all, axis=1) - lb_all[:, :1]
    for l in range(DEPTH):
        mod = jax.nn.silu(c) @ p['ada_w'][l] + p['ada_b'][l]
        sh1, sc1, g1, sh2, sc2, g2 = jnp.split(mod[:, None, :], 6, axis=-1)
        h = rmsnorm(x, p['norm1_w'][l]) * (1 + sc1) + sh1
        x = x + g1 * token_mixer(h, l, lb_all[0, l], lb_all[1, l], p)
        h = rmsnorm(x, p['norm2_w'][l]) * (1 + sc2) + sh2
        x = x + g2 * swiglu(h, p['ffn_wg'][l], p['ffn_wu'][l], p['ffn_wd'][l])
    return rmsnorm(x, p['final_norm_w'])


def setup_inputs(seed: int = 0) -> dict:
    key = jax.random.key(seed)
    ks = jax.random.split(key, 34)
    f32 = jnp.float32

    def nrm(i, shape, scale):
        return scale * jax.random.normal(ks[i], shape, f32)

    def gain(i, shape):
        return 1.0 + 0.05 * jax.random.normal(ks[i], shape, f32)

    u = jax.random.uniform(ks[30], (DEPTH, 2, RG_W), f32, minval=0.9, maxval=0.999)
    s = u ** (1.0 / RG_C)
    rg_lambda = jnp.log(s) - jnp.log1p(-s)
    return {
        'x_prompt': nrm(0, (BATCH, SEQ, D_MODEL), 1.0),
        'x_sample': nrm(1, (DEC_BATCH, DEC_SEQ, D_MODEL), 1.0),
        'c_prompt': nrm(2, (BATCH, D_MODEL), 1.0),
        'c_sample': nrm(3, (DEC_BATCH, D_MODEL), 1.0),
        'w_in': nrm(4, (DEPTH, D_MODEL, D_IN), D_MODEL ** -0.5),
        'w_out': nrm(5, (DEPTH, D_MIX, D_MODEL), D_MIX ** -0.5),
        'out_norm_w': gain(6, (DEPTH, D_MIX)),
        'ada_w': nrm(7, (DEPTH, D_MODEL, 6 * D_MODEL), 0.5 * D_MODEL ** -0.5),
        'ada_b': nrm(8, (DEPTH, 6 * D_MODEL), 0.02),
        'norm1_w': gain(9, (DEPTH, D_MODEL)),
        'norm2_w': gain(10, (DEPTH, D_MODEL)),
        'final_norm_w': gain(11, (D_MODEL,)),
        'hy_conv_w': nrm(12, (DEPTH, HY_SHORT, HY_IN), HY_SHORT ** -0.5),
        'hy_conv_b': nrm(13, (DEPTH, HY_IN), 0.02),
        'hy_w1': nrm(14, (DEPTH, HY_EMB, HY_FFN), HY_EMB ** -0.5),
        'hy_b1': nrm(15, (DEPTH, HY_FFN), 0.1),
        'hy_w2': nrm(16, (DEPTH, HY_FFN, HY_FFN), HY_FFN ** -0.5),
        'hy_b2': nrm(17, (DEPTH, HY_FFN), 0.1),
        'hy_w3': nrm(18, (DEPTH, HY_FFN, HY_FFN), HY_FFN ** -0.5),
        'hy_b3': nrm(19, (DEPTH, HY_FFN), 0.1),
        'hy_w4': nrm(20, (DEPTH, HY_FFN, 2 * HY_W), HY_FFN ** -0.5),
        'hy_freq': gain(21, (DEPTH, HY_FFN)),
        'hy_bias': nrm(22, (DEPTH, HY_W), 0.5),
        'hg_lb_logits': nrm(23, (2, DEPTH, HG_W), 0.1),
        'rg_conv_w': nrm(24, (DEPTH, RG_CONV, RG_W), RG_CONV ** -0.5),
        'rg_conv_b': nrm(25, (DEPTH, RG_W), 0.02),
        'rg_wa': nrm(26, (DEPTH, 2, RG_HEADS, RG_HD, RG_HD), RG_HD ** -0.5),
        'rg_ba': nrm(27, (DEPTH, 2, RG_W), 0.1),
        'rg_wx': nrm(28, (DEPTH, 2, RG_HEADS, RG_HD, RG_HD), RG_HD ** -0.5),
        'rg_bx': nrm(29, (DEPTH, 2, RG_W), 0.1),
        'rg_lambda': rg_lambda,
        'ffn_wg': nrm(31, (DEPTH, D_MODEL, D_FF), D_MODEL ** -0.5),
        'ffn_wu': nrm(32, (DEPTH, D_MODEL, D_FF), D_MODEL ** -0.5),
        'ffn_wd': nrm(33, (DEPTH, D_FF, D_MODEL), D_FF ** -0.5),
    }


def reference(x_prompt, x_sample, c_prompt, c_sample, w_in, w_out, out_norm_w, ada_w, ada_b,
              norm1_w, norm2_w, final_norm_w, hy_conv_w, hy_conv_b, hy_w1, hy_b1, hy_w2, hy_b2,
              hy_w3, hy_b3, hy_w4, hy_freq, hy_bias, hg_lb_logits, rg_conv_w, rg_conv_b, rg_wa,
              rg_ba, rg_wx, rg_bx, rg_lambda, ffn_wg, ffn_wu, ffn_wd):
    p = dict(w_in=w_in, w_out=w_out, out_norm_w=out_norm_w, ada_w=ada_w, ada_b=ada_b,
             norm1_w=norm1_w, norm2_w=norm2_w, final_norm_w=final_norm_w,
             hy_conv_w=hy_conv_w, hy_conv_b=hy_conv_b, hy_w1=hy_w1, hy_b1=hy_b1, hy_w2=hy_w2,
             hy_b2=hy_b2, hy_w3=hy_w3, hy_b3=hy_b3, hy_w4=hy_w4, hy_freq=hy_freq, hy_bias=hy_bias,
             hg_lb_logits=hg_lb_logits, rg_conv_w=rg_conv_w, rg_conv_b=rg_conv_b, rg_wa=rg_wa,
             rg_ba=rg_ba, rg_wx=rg_wx, rg_bx=rg_bx, rg_lambda=rg_lambda,
             ffn_wg=ffn_wg, ffn_wu=ffn_wu, ffn_wd=ffn_wd)
    y_prompt = trunk(x_prompt, c_prompt, p)
    y_sample = trunk(x_sample, c_sample, p)
    return (y_prompt, y_sample)
```

```cpp
#include <hip/hip_runtime.h>
#include <hip/hip_cooperative_groups.h>
#include <cstdio>
namespace cg = cooperative_groups;
namespace pg8 {
#define PG8_LAS __attribute__((address_space(3)))
typedef unsigned short bf16_t;
typedef short bf16x8 __attribute__((ext_vector_type(8)));
typedef float f32x4 __attribute__((ext_vector_type(4)));
typedef unsigned u32x4 __attribute__((ext_vector_type(4)));
constexpr int BM = 256, BK = 64, HALF = 128, HTB = HALF * BK * 2  , STAGE_BYTES = 8 * HTB, NXCD = 8, WGM = 8;

__host__ __device__ __forceinline__ int lds_byte(int r, int c) { const int st = (r >> 4) * 2 + (c >> 5), rr = r & 15, cc = c & 31, ob = rr * 64 + cc * 2; return st * 1024 + (ob ^ (((ob >> 9) & 1) << 5)); }
__host__ __device__ __forceinline__ void stage_rc(int b, int& R, int& C) { const int st = b / 1024, sb = b % 1024, swz = sb ^ (((sb >> 9) & 1) << 5); R = (st >> 1) * 16 + swz / 64; C = (st & 1) * 32 + (swz % 64) / 2; }
__host__ __device__ __forceinline__ int perm32(int rho) { const int n = rho >> 4, i = rho & 15; return 8 * (i >> 2) + 4 * n + (i & 3); }

struct Unit { int pm, pn; };
struct Gemm { const bf16_t* A; const bf16_t* Bt; int M, N, K; };

struct StaticOrder {
    int nM, nN, nwg, G, c;
    __host__ __device__ void init(int M, int N, int G_, int c_) { nM = M / BM; nN = N / BM; nwg = nM * nN; G = G_; c = c_; }
    __host__ __device__ bool next(int i, Unit& u) const {
        const long L = (long)i * G + c; if (L >= nwg) return false;
        int wgid = (int)L; { const int q = nwg / NXCD, r = nwg % NXCD, xcd = wgid % NXCD, off = wgid / NXCD; wgid = (xcd < r ? xcd * (q + 1) : r * (q + 1) + (xcd - r) * q) + off; }
        const int nig = WGM * nN, gid = wgid / nig, fm = gid * WGM, gsz = (nM - fm) < WGM ? (nM - fm) : WGM;
        u.pm = fm + ((wgid % nig) % gsz); u.pn = (wgid % nig) / gsz; return true;
    }
    __device__ __forceinline__ void a_ready(const Unit&) const {}
    __device__ __forceinline__ void done(const Unit&) const {}
};
__device__ __forceinline__ unsigned cvt_pk_bf16(float lo, float hi) { unsigned r; asm volatile("v_cvt_pk_bf16_f32 %0, %1, %2" : "=v"(r) : "v"(lo), "v"(hi)); return r; }
typedef float f32x2 __attribute__((ext_vector_type(2)));
template <class Epi, class Sched, bool STAMP = false>
__device__ __forceinline__ void gemm_phase(PG8_LAS unsigned char* lds, const Gemm g, const Sched& S, const Epi& E, unsigned long long* stamps) {
    int tid_ = threadIdx.x; asm volatile("" : "+v"(tid_)); const int tid = tid_, wid = __builtin_amdgcn_readfirstlane(tid >> 6), lane = tid & 63, wr = wid >> 2, wc = wid & 3, fr = lane & 15, fq = lane >> 4;
    const int K = g.K, nt = K / BK;
    int ts_lo = 0, ts_hi = 0, nts = 0; const unsigned long long rt_entry = STAMP ? (unsigned long long)wall_clock64() : 0ull;
#define PG8_STAMP() do { if (STAMP && wid == 0 && nts < 64) { const unsigned long long _c = (unsigned long long)clock64(); \
        ts_lo = (lane == nts) ? (int)(unsigned)_c : ts_lo; ts_hi = (lane == nts) ? (int)(unsigned)(_c >> 32) : ts_hi; ++nts; } } while (0)
    PG8_STAMP();
    unsigned voffA[2], voffB[2];
#pragma unroll
    for (int i = 0; i < 2; ++i) { int R, C; stage_rc(tid * 16 + i * 8192, R, C); const int Rb = Epi::PERM ? ((R & ~31) + perm32(R & 31)) : R;
        voffA[i] = (unsigned)(R * K + C) * 2u; voffB[i] = (unsigned)(Rb * K + C) * 2u; }
    const size_t kstep = (size_t)(BK * 2);
    const size_t hstep = (size_t)HALF * K * 2;
    const size_t tstep = 2 * hstep;
    const unsigned ldsw = (unsigned)wid * 1024u;
    const int aoff = lds_byte(wr * 64 + fr, fq * 8), boff = lds_byte(wc * 32 + fr, fq * 8);
#define PG8_SA(b, h) (((b) * 2 + (h)) * HTB)
#define PG8_SB(b, h) ((4 + (b) * 2 + (h)) * HTB)
#define PG8_STAGE(bufoff, gbase, voff) do { _Pragma("unroll") for (int _i = 0; _i < 2; ++_i) \
        __builtin_amdgcn_global_load_lds((const unsigned*)((const char*)(gbase) + (voff)[_i]), (PG8_LAS unsigned*)(lds + (bufoff) + ldsw + _i * 8192), 16, 0, 0); } while (0)
#define PG8_LDA(dst, b, h) do { _Pragma("unroll") for (int m = 0; m < 4; ++m) _Pragma("unroll") for (int k = 0; k < 2; ++k) dst[m][k] = *(const PG8_LAS bf16x8*)(lds + PG8_SA(b, h) + aoff + m * 2048 + k * 1024); } while (0)
#define PG8_LDB(dst, b, h) do { _Pragma("unroll") for (int n = 0; n < 2; ++n) _Pragma("unroll") for (int k = 0; k < 2; ++k) dst[n][k] = *(const PG8_LAS bf16x8*)(lds + PG8_SB(b, h) + boff + n * 2048 + k * 1024); } while (0)
#define PG8_MMA(ai, bj, At, Bt) do { __builtin_amdgcn_s_setprio(1); _Pragma("unroll") for (int m = 0; m < 4; ++m) _Pragma("unroll") for (int n = 0; n < 2; ++n) _Pragma("unroll") for (int k = 0; k < 2; ++k) \
        acc[ai][bj][m][n] = __builtin_amdgcn_mfma_f32_16x16x32_bf16(Bt[n][k], At[m][k], acc[ai][bj][m][n], 0, 0, 0); __builtin_amdgcn_s_setprio(0); } while (0)
#define PG8_WAIT_V(n) asm volatile("s_waitcnt vmcnt(" #n ")" ::: "memory")
#define PG8_WAIT_L(n) asm volatile("s_waitcnt lgkmcnt(" #n ")" ::: "memory")
#define PG8_BAR __builtin_amdgcn_s_barrier()
#define PG8_SCHED __builtin_amdgcn_sched_barrier(0)
    Unit cur, nxt; int ui = 0;
    if (!S.next(0, cur)) return;
    f32x4 acc[2][2][4][2];
#pragma unroll
    for (int a = 0; a < 2; ++a)
#pragma unroll
        for (int b = 0; b < 2; ++b)
#pragma unroll
            for (int m = 0; m < 4; ++m)
#pragma unroll
                for (int n = 0; n < 2; ++n) acc[a][b][m][n] = (f32x4){0.f, 0.f, 0.f, 0.f};
    bf16x8 At[4][2], B0[2][2], B1[2][2];
    const char* cA = (const char*)g.A + (size_t)cur.pm * tstep; const char* cB = (const char*)g.Bt + (size_t)cur.pn * tstep;
    S.a_ready(cur);
    PG8_STAGE(PG8_SB(0, 0), cB, voffB); PG8_STAGE(PG8_SA(0, 0), cA, voffA); PG8_STAGE(PG8_SB(0, 1), cB + hstep, voffB); PG8_STAGE(PG8_SA(0, 1), cA + hstep, voffA);
    if (wr == 1) PG8_BAR;
    PG8_WAIT_V(4); PG8_BAR;
    PG8_STAGE(PG8_SB(1, 0), cB + kstep, voffB); PG8_STAGE(PG8_SA(1, 0), cA + kstep, voffA); PG8_STAGE(PG8_SB(1, 1), cB + hstep + kstep, voffB);
    PG8_WAIT_V(6); PG8_BAR;
    PG8_STAMP();
    for (;;) {
        const bool has_next = S.next(ui + 1, nxt);
        const char* nA = has_next ? (const char*)g.A + (size_t)nxt.pm * tstep : cA; const char* nB = has_next ? (const char*)g.Bt + (size_t)nxt.pn * tstep : cB;
        for (int t = 0; t < nt; t += 2) {
            const bool last = (t == nt - 2);
            const char* a1 = cA + (size_t)(t + 1) * kstep;
            const char* a2 = last ? nA : cA + (size_t)(t + 2) * kstep; const char* b2 = last ? nB : cB + (size_t)(t + 2) * kstep;
            const char* a3 = a2 + kstep; const char* b3 = b2 + kstep;
            if (last && has_next) S.a_ready(nxt);
            PG8_LDB(B0, 0, 0); PG8_SCHED; PG8_LDA(At, 0, 0); PG8_STAGE(PG8_SA(1, 1), a1 + hstep, voffA);
            PG8_WAIT_L(8); PG8_BAR; PG8_WAIT_L(0); PG8_MMA(0, 0, At, B0); PG8_BAR; PG8_SCHED;
            PG8_LDB(B1, 0, 1); PG8_STAGE(PG8_SB(0, 0), b2, voffB);
            PG8_BAR; PG8_WAIT_L(0); PG8_MMA(0, 1, At, B1); PG8_BAR;
            PG8_LDA(At, 0, 1); PG8_STAGE(PG8_SA(0, 0), a2, voffA);
            PG8_BAR; PG8_WAIT_L(0); PG8_MMA(1, 0, At, B0); PG8_BAR; PG8_SCHED;
            PG8_STAGE(PG8_SB(0, 1), b2 + hstep, voffB);
            PG8_WAIT_V(6); PG8_BAR; PG8_MMA(1, 1, At, B1); PG8_BAR;
            PG8_LDB(B0, 1, 0); PG8_SCHED; PG8_LDA(At, 1, 0); PG8_STAGE(PG8_SA(0, 1), a2 + hstep, voffA);
            PG8_WAIT_L(8); PG8_BAR; PG8_WAIT_L(0); PG8_MMA(0, 0, At, B0); PG8_BAR; PG8_SCHED;
            PG8_LDB(B1, 1, 1); PG8_STAGE(PG8_SB(1, 0), b3, voffB);
            PG8_BAR; PG8_WAIT_L(0); PG8_MMA(0, 1, At, B1); PG8_BAR;
            PG8_LDA(At, 1, 1); PG8_STAGE(PG8_SA(1, 0), a3, voffA);
            PG8_BAR; PG8_WAIT_L(0); PG8_MMA(1, 0, At, B0); PG8_BAR; PG8_SCHED;
            PG8_STAGE(PG8_SB(1, 1), b3 + hstep, voffB);
            PG8_WAIT_V(6); PG8_BAR; PG8_MMA(1, 1, At, B1); PG8_BAR;
        }
        PG8_STAMP();
        if constexpr (!Epi::AFTER_DRAIN) { E(acc, cur, wr, wc, fr, fq); S.done(cur); }
        PG8_STAMP();
        if (!has_next) break;
#pragma unroll
        for (int a = 0; a < 2; ++a)
#pragma unroll
            for (int b = 0; b < 2; ++b)
#pragma unroll
                for (int m = 0; m < 4; ++m)
#pragma unroll
                    for (int n = 0; n < 2; ++n) acc[a][b][m][n] = (f32x4){0.f, 0.f, 0.f, 0.f};
        cur = nxt; cA = nA; cB = nB; ++ui;
    }
    PG8_WAIT_V(0);
    if (wr == 0) PG8_BAR;
    PG8_BAR;
    if constexpr (Epi::AFTER_DRAIN) { E.fused(acc, cur, wr, wc, fr, fq, lds, wid, lane); S.done(cur); }
    PG8_STAMP();
    if (STAMP && wid == 0) { stamps[lane] = lane < nts ? (((unsigned long long)(unsigned)ts_hi << 32) | (unsigned)ts_lo) : 0ull;
        if (lane == 62) stamps[62] = rt_entry; if (lane == 63) stamps[63] = (unsigned long long)wall_clock64(); }
#undef PG8_STAMP
#undef PG8_SA
#undef PG8_SB
#undef PG8_STAGE
#undef PG8_LDA
#undef PG8_LDB
#undef PG8_MMA
#undef PG8_WAIT_V
#undef PG8_WAIT_L
#undef PG8_BAR
#undef PG8_SCHED
}
}
typedef unsigned short bf16_t;
typedef float f32x4 __attribute__((ext_vector_type(4)));
typedef unsigned u32x4 __attribute__((ext_vector_type(4)));
typedef unsigned u32x2 __attribute__((ext_vector_type(2)));
#define LDSP PG8_LAS

constexpr int DM = 1024, DIN = 3840, DFF = 2816, MH = 32768;
constexpr int GLEN = 2 * 16384 + 64;
constexpr int LDS_BYTES = 150 * 1024;
constexpr size_t WS_WIN = 0, WS_WOUT = 15728640, WS_WGU = 19922944, WS_WD = 42991616, WS_MOD = 54525952, WS_LB = 55017472,
                 WS_RGC = 55025664  , WS_G = 61317120, WS_VT = 78127104, WS_YT = 94904320, WS_OF = 128458752, WS_OB = 162013184,
                 WS_H = 195567616, WS_U = 262676480, WS_END = 514334720;
constexpr float EPSN = 1e-6f;

struct P { const void* ptr[36]; };
#define PIN(i) ((const float*)p.ptr[(i) + z_])
#define PWS ((unsigned char*)p.ptr[35 + z_])
#define POUT ((float*)p.ptr[34 + z_])
#define OPQ_Z int z_ = 0; asm volatile("" : "+s"(z_));

__device__ __forceinline__ float bf2f(bf16_t v) { return __uint_as_float(((unsigned)v) << 16); }
__device__ __forceinline__ bf16_t f2bf(float f) { unsigned u = __float_as_uint(f); u += 0x7FFFu + ((u >> 16) & 1u); return (bf16_t)(u >> 16); }
__device__ __forceinline__ unsigned pk2(float lo, float hi) { return (unsigned)f2bf(lo) | ((unsigned)f2bf(hi) << 16); }
__device__ __forceinline__ float lo16(unsigned w) { return __uint_as_float(w << 16); }
__device__ __forceinline__ float hi16(unsigned w) { return __uint_as_float(w & 0xffff0000u); }
__device__ __forceinline__ float sigm(float x) { return 1.0f / (1.0f + expf(-x)); }
__device__ __forceinline__ float wave_sum(float v) {
#pragma unroll
    for (int o = 32; o >= 1; o >>= 1) v += __shfl_xor(v, o);
    return v;
}

struct EpiRes {
    static constexpr bool PERM = false, AFTER_DRAIN = false;
    const float* base; float* out; const float* gate; int lshift;
    __device__ __forceinline__ void operator()(const f32x4 (&acc)[2][2][4][2], const pg8::Unit& u, int wr, int wc, int fr, int fq) const {
        const int row0 = u.pm * 256 + wr * 64 + fr, col0 = u.pn * 256 + wc * 32 + 4 * fq;
        const float* g = gate + (size_t)((u.pm * 256) >> lshift) * 6144 + col0;
        f32x4 gv[2][2];
#pragma unroll
        for (int bj = 0; bj < 2; ++bj)
#pragma unroll
            for (int n = 0; n < 2; ++n) gv[bj][n] = *(const f32x4*)(g + bj * 128 + n * 16);
#pragma unroll
        for (int ai = 0; ai < 2; ++ai)
#pragma unroll
            for (int m = 0; m < 4; ++m) { const size_t off = (size_t)(row0 + ai * 128 + m * 16) * DM + col0;
#pragma unroll
                for (int bj = 0; bj < 2; ++bj)
#pragma unroll
                    for (int n = 0; n < 2; ++n) { const f32x4 bs = *(const f32x4*)(base + off + bj * 128 + n * 16); *(f32x4*)(out + off + bj * 128 + n * 16) = bs + gv[bj][n] * acc[ai][bj][m][n]; }
                asm volatile("" ::: "memory"); }
    }
};
struct EpiSwi {
    static constexpr bool PERM = true, AFTER_DRAIN = false;
    bf16_t* O;
    __device__ __forceinline__ void operator()(const f32x4 (&acc)[2][2][4][2], const pg8::Unit& u, int wr, int wc, int fr, int fq) const {
        const int row0 = u.pm * 256 + wr * 64 + fr, col0 = u.pn * 128 + wc * 32 + 8 * fq;
#pragma unroll
        for (int ai = 0; ai < 2; ++ai)
#pragma unroll
            for (int m = 0; m < 4; ++m) { bf16_t* rowp = O + (size_t)(row0 + ai * 128 + m * 16) * DFF + col0;
                float r[8];
#pragma unroll
                for (int n = 0; n < 2; ++n)
#pragma unroll
                    for (int j = 0; j < 4; ++j) { const float gt = acc[ai][0][m][n][j], up = acc[ai][1][m][n][j]; r[n * 4 + j] = gt * __builtin_amdgcn_rcpf(1.0f + __expf(-gt)) * up; }
                u32x4 w; w.x = pg8::cvt_pk_bf16(r[0], r[1]); w.y = pg8::cvt_pk_bf16(r[2], r[3]); w.z = pg8::cvt_pk_bf16(r[4], r[5]); w.w = pg8::cvt_pk_bf16(r[6], r[7]);
                *(u32x4*)rowp = w; }
    }
};
struct EpiB16 {
    static constexpr bool PERM = true, AFTER_DRAIN = false;
    bf16_t* O; int ldc;
    __device__ __forceinline__ void operator()(const f32x4 (&acc)[2][2][4][2], const pg8::Unit& u, int wr, int wc, int fr, int fq) const {
        const int row0 = u.pm * 256 + wr * 64 + fr, col0 = u.pn * 256 + wc * 32 + 8 * fq;
#pragma unroll
        for (int ai = 0; ai < 2; ++ai)
#pragma unroll
            for (int m = 0; m < 4; ++m) { bf16_t* rowp = O + (size_t)(row0 + ai * 128 + m * 16) * ldc + col0;
#pragma unroll
                for (int bj = 0; bj < 2; ++bj) { const f32x4 v0 = acc[ai][bj][m][0], v1 = acc[ai][bj][m][1];
                    u32x4 w; w.x = pg8::cvt_pk_bf16(v0[0], v0[1]); w.y = pg8::cvt_pk_bf16(v0[2], v0[3]); w.z = pg8::cvt_pk_bf16(v1[0], v1[1]); w.w = pg8::cvt_pk_bf16(v1[2], v1[3]);
                    *(u32x4*)(rowp + bj * 128) = w; } }
    }
};

__device__ __forceinline__ void tr_tile(const float* __restrict__ src, bf16_t* __restrict__ dst, int K, int N, int tk, int tn, int gu, float* sm) {
    int tid_ = threadIdx.x; asm volatile("" : "+v"(tid_)); OPQ_Z const int k0 = tk * 64, n0 = tn * 64, tid = tid_;
    for (int e = tid; e < 4096; e += 512) { const int r = e >> 6, c = e & 63; sm[r * 65 + c] = src[(size_t)(k0 + r) * N + n0 + c]; }
    __syncthreads();
    for (int e = tid; e < 4096; e += 512) { const int n = e >> 6, k = e & 63, nn = n0 + n;
        const int drow = gu == 0 ? nn : ((nn >> 7) * 256 + (gu == 2 ? 128 : 0) + (nn & 127));
        dst[(size_t)drow * K + k0 + k] = f2bf(sm[k * 65 + n]); }
    __syncthreads();
}
__device__ __forceinline__ void init_phase(const P& p, unsigned char* lds) {
    float* sm = (float*)lds;
    int tid_ = threadIdx.x; asm volatile("" : "+v"(tid_)); OPQ_Z const int tid = tid_, G = gridDim.x, bid = blockIdx.x;
    bf16_t* win = (bf16_t*)(PWS + WS_WIN); bf16_t* wout = (bf16_t*)(PWS + WS_WOUT); bf16_t* wgu = (bf16_t*)(PWS + WS_WGU); bf16_t* wd = (bf16_t*)(PWS + WS_WD);
    float* mod = (float*)(PWS + WS_MOD); float* lb = (float*)(PWS + WS_LB);
#pragma unroll 1
    for (int it = bid; it < 2 * 3328; it += G) {
        const int l = it / 3328, r = it % 3328;
        const float* src; bf16_t* dst; int K, N, gu = 0, tl;
        if (r < 960) { src = PIN(4) + (size_t)l * 1024 * 3840; dst = win + (size_t)l * 3840 * 1024; K = 1024; N = 3840; tl = r; }
        else if (r < 1216) { src = PIN(5) + (size_t)l * 1024 * 1024; dst = wout + (size_t)l * 1024 * 1024; K = 1024; N = 1024; tl = r - 960; }
        else if (r < 1920) { src = PIN(31) + (size_t)l * 1024 * 2816; dst = wgu + (size_t)l * 5632 * 1024; K = 1024; N = 2816; gu = 1; tl = r - 1216; }
        else if (r < 2624) { src = PIN(32) + (size_t)l * 1024 * 2816; dst = wgu + (size_t)l * 5632 * 1024; K = 1024; N = 2816; gu = 2; tl = r - 1920; }
        else { src = PIN(33) + (size_t)l * 2816 * 1024; dst = wd + (size_t)l * 1024 * 2816; K = 2816; N = 1024; tl = r - 2624; }
        const int ntn = N / 64;
        tr_tile(src, dst, K, N, tl / ntn, tl % ntn, gu, sm);
    }
    for (int e = tid; e < 10240; e += 512) { const int r = e >> 10, k = e & 1023; const float c = r < 8 ? PIN(2)[r * 1024 + k] : PIN(3)[(r - 8) * 1024 + k]; sm[e] = c * sigm(c); }
    __syncthreads();
    float* red = sm + 10240;
#pragma unroll 1
    for (int it = bid; it < 384; it += G) {
        const int l = it / 192, cgp = it % 192, cl = tid & 31, ks = tid >> 5;
        float acc[10];
#pragma unroll
        for (int r = 0; r < 10; ++r) acc[r] = 0.f;
        const float* w = PIN(7) + (size_t)l * 1024 * 6144 + cgp * 32 + cl;
        for (int i = 0; i < 64; ++i) { const int k = ks * 64 + i; const float wv = w[(size_t)k * 6144];
#pragma unroll
            for (int r = 0; r < 10; ++r) acc[r] += sm[r * 1024 + k] * wv; }
#pragma unroll
        for (int r = 0; r < 10; ++r) red[(ks * 10 + r) * 32 + cl] = acc[r];
        __syncthreads();
        if (tid < 320) { const int r = tid >> 5; float s = 0.f; for (int k2 = 0; k2 < 16; ++k2) s += red[(k2 * 10 + r) * 32 + cl];
            mod[(size_t)(l * 10 + r) * 6144 + cgp * 32 + cl] = s + PIN(8)[l * 6144 + cgp * 32 + cl]; }
        __syncthreads();
    }
    if (bid == G - 1) for (int e = tid; e < 1024; e += 512) { const int d = e >> 9, j = e & 511; const float x0 = PIN(23)[(d * 2 + 0) * 512 + j], x1 = PIN(23)[(d * 2 + 1) * 512 + j];
        const float m = fmaxf(x0, x1), e0 = expf(x0 - m), e1 = expf(x1 - m); lb[(d * 2 + 0) * 512 + j] = 0.f; lb[(d * 2 + 1) * 512 + j] = e1 / (e0 + e1); }
}

__device__ __forceinline__ void filter_gen(const P& p, unsigned char* lds, int l, int L) {
    float* zf = (float*)lds; float* ha = zf + 64 * 33; float* hb = ha + 64 * 65;
    int tid_ = threadIdx.x; asm volatile("" : "+v"(tid_)); OPQ_Z const int tid = tid_, G = gridDim.x, bid = blockIdx.x;
    bf16_t* Gf = (bf16_t*)(PWS + WS_G);
    const float* w1 = PIN(14) + l * 33 * 64; const float* b1 = PIN(15) + l * 64; const float* w2 = PIN(16) + l * 4096; const float* b2 = PIN(17) + l * 64;
    const float* w3 = PIN(18) + l * 4096; const float* b3 = PIN(19) + l * 64; const float* w4 = PIN(20) + l * 64 * 512; const float* fr = PIN(21) + l * 64;
    for (int e = bid * 512 + tid; e < 256 * 65; e += G * 512) { const int ch = e / 65, q = e % 65; const int idx = q < 33 ? q : 32 + 2 * L + (q - 33); Gf[(size_t)ch * GLEN + idx] = 0; }
    const int pos = tid & 63, jg = __builtin_amdgcn_readfirstlane(tid >> 6);
    const float d_lo = -4.605170186f / 1.5f, d_hi = -4.605170186f / 0.3f;
#pragma unroll 1
    for (int tile = bid; tile < L / 64; tile += G) {
        const int n0 = tile * 64;
        for (int e = tid; e < 64 * 33; e += 512) { const int ps = e / 33, i = e % 33; const float n = (float)(n0 + ps); float val;
            if (i == 0) val = n / (float)(L - 1);
            else { const int bnd = (i - 1) & 15; const float fb = 1e-4f + (float)bnd * ((15.0f - 1e-4f) / 15.0f); const float ang = (fb * n) * (6.283185307179586f / (float)L); val = (i <= 16) ? cosf(ang) : -sinf(ang); }
            zf[ps * 33 + i] = val; }
        __syncthreads();
#pragma unroll 1
        for (int jj = 0; jj < 8; ++jj) { const int j = jg * 8 + jj; float s = b1[j]; for (int i = 0; i < 33; ++i) s += zf[pos * 33 + i] * w1[i * 64 + j]; ha[pos * 65 + j] = sinf(fr[j] * s); }
        __syncthreads();
#pragma unroll 1
        for (int jj = 0; jj < 8; ++jj) { const int j = jg * 8 + jj; float s = b2[j]; for (int i = 0; i < 64; ++i) s += ha[pos * 65 + i] * w2[i * 64 + j]; hb[pos * 65 + j] = sinf(fr[j] * s); }
        __syncthreads();
#pragma unroll 1
        for (int jj = 0; jj < 8; ++jj) { const int j = jg * 8 + jj; float s = b3[j]; for (int i = 0; i < 64; ++i) s += hb[pos * 65 + i] * w3[i * 64 + j]; ha[pos * 65 + j] = sinf(fr[j] * s); }
        __syncthreads();
        const int n = n0 + pos; const float tpos = (float)n / (float)(L - 1);
#pragma unroll 1
        for (int hp = 0; hp < 2; ++hp) {
            float acc[32];
#pragma unroll
            for (int cc = 0; cc < 32; ++cc) acc[cc] = 0.f;
#pragma unroll 1
            for (int i = 0; i < 64; ++i) { const float hv = ha[pos * 65 + i]; const float* wr = w4 + i * 512 + jg * 64 + hp * 32;
#pragma unroll
                for (int cc = 0; cc < 32; ++cc) acc[cc] += hv * wr[cc]; }
#pragma unroll
            for (int cc = 0; cc < 32; ++cc) { const int c2 = jg * 64 + hp * 32 + cc, ch = c2 & 255; const float delta = fabsf(d_lo + (float)ch * ((d_hi - d_lo) / 255.0f));
                const float val = acc[cc] * expf(-tpos * delta);
                if (c2 < 256) Gf[(size_t)ch * GLEN + 32 + L - n] = f2bf(val); else if (n > 0) Gf[(size_t)ch * GLEN + 32 + L + n] = f2bf(val); }
        }
        __syncthreads();
    }
}

__device__ __forceinline__ void norm_mod(const float* x, const float* w, const float* modl, int sc_off, int sh_off, int rbase, int lshift, bf16_t* hb) {
    int tid_ = threadIdx.x; asm volatile("" : "+v"(tid_)); OPQ_Z const int tid = tid_, lane = tid & 63, wid = tid >> 6, G = gridDim.x;
#pragma unroll 1
    for (int row = blockIdx.x * 8 + wid; row < MH; row += G * 8) {
        const f32x4* xr = (const f32x4*)(x + (size_t)row * DM);
        f32x4 v[4]; float ss = 0.f;
#pragma unroll
        for (int i = 0; i < 4; ++i) { v[i] = xr[lane + 64 * i]; ss += v[i][0] * v[i][0] + v[i][1] * v[i][1] + v[i][2] * v[i][2] + v[i][3] * v[i][3]; }
        ss = wave_sum(ss);
        const float rstd = rsqrtf(ss * (1.0f / 1024.0f) + EPSN);
        const float* mb = modl + (size_t)(rbase + (row >> lshift)) * 6144;
#pragma unroll
        for (int i = 0; i < 4; ++i) { const int col = (lane + 64 * i) * 4; const f32x4 wv = *(const f32x4*)(w + col), sc = *(const f32x4*)(mb + sc_off + col), sh = *(const f32x4*)(mb + sh_off + col);
            const f32x4 h = v[i] * rstd * wv * (1.0f + sc) + sh; u32x2 o; o.x = pk2(h[0], h[1]); o.y = pk2(h[2], h[3]); *(u32x2*)(hb + (size_t)row * DM + col) = o; }
    }
}
__device__ __forceinline__ void final_norm(float* x, const float* w) {
    int tid_ = threadIdx.x; asm volatile("" : "+v"(tid_)); OPQ_Z const int tid = tid_, lane = tid & 63, wid = tid >> 6, G = gridDim.x;
#pragma unroll 1
    for (int row = blockIdx.x * 8 + wid; row < MH; row += G * 8) {
        f32x4* xr = (f32x4*)(x + (size_t)row * DM);
        f32x4 v[4]; float ss = 0.f;
#pragma unroll
        for (int i = 0; i < 4; ++i) { v[i] = xr[lane + 64 * i]; ss += v[i][0] * v[i][0] + v[i][1] * v[i][1] + v[i][2] * v[i][2] + v[i][3] * v[i][3]; }
        ss = wave_sum(ss);
        const float rstd = rsqrtf(ss * (1.0f / 1024.0f) + EPSN);
#pragma unroll
        for (int i = 0; i < 4; ++i) { const int col = (lane + 64 * i) * 4; const f32x4 wv = *(const f32x4*)(w + col); xr[lane + 64 * i] = v[i] * rstd * wv; }
    }
}
template <bool PASS_C>
__device__ __forceinline__ void rg_tile(const P& p, unsigned char* lds, int l, int rowb, int L, int t0, const bf16_t* __restrict__ ub, bf16_t* __restrict__ yb, const float (&wA)[64], const float (&wX)[64], float ba, float bx, float sp, int tid) {
    OPQ_Z
    float* xr = (float*)lds; float* hs0 = xr + 32 * 256; float* hs1 = hs0 + 32 * 256;
    const int dir = tid >> 8, j = tid & 255, head = j >> 6;
    const int tile = (rowb + t0) >> 5;
    float* CA = (float*)(PWS + WS_RGC); float* CB = CA + 524288; float* CIN = CB + 524288;
    {
        const float* cw = PIN(24) + l * 4 * 256; const float cb = PIN(25)[l * 256 + j];
        const float w0 = cw[j], w1 = cw[256 + j], w2 = cw[512 + j], w3 = cw[768 + j];
#pragma unroll 4
        for (int r = 0; r < 16; ++r) { const int t = dir + 2 * r, tok = t0 + t; float a = cb;
            const bf16_t* up = ub + (size_t)(rowb + tok) * DIN + 3328 + j;
            if (tok - 2 >= 0) a += w0 * bf2f(up[-2 * DIN]);
            if (tok - 1 >= 0) a += w1 * bf2f(up[-DIN]);
            a += w2 * bf2f(up[0]);
            if (tok + 1 < L) a += w3 * bf2f(up[DIN]);
            xr[t * 256 + j] = a; }
    }
    float h = PASS_C ? CIN[(size_t)(tile * 2 + dir) * 256 + j] : 0.f, ap = 1.f;
    __syncthreads();
#pragma unroll 1
    for (int step = 0; step < 32; ++step) { const int t = dir ? 31 - step : step;
        const f32x4* xp = (const f32x4*)(xr + t * 256 + head * 64);
        float sa = ba, sx = bx;
#pragma unroll
        for (int i4 = 0; i4 < 16; ++i4) { const f32x4 xv = xp[i4];
            sa += xv[0] * wA[4 * i4] + xv[1] * wA[4 * i4 + 1] + xv[2] * wA[4 * i4 + 2] + xv[3] * wA[4 * i4 + 3];
            sx += xv[0] * wX[4 * i4] + xv[1] * wX[4 * i4 + 1] + xv[2] * wX[4 * i4 + 2] + xv[3] * wX[4 * i4 + 3];
            if ((i4 & 3) == 3) asm volatile("" ::: "memory"); }
        const float r = sigm(sa), ig = sigm(sx);
        const float la = -8.0f * r * sp, a = expf(la), bt = sqrtf(-expm1f(2.0f * la)) * ig * xr[t * 256 + j];
        h = a * h + bt; ap *= a;
        if (PASS_C) { if (dir) hs1[t * 256 + j] = h; else hs0[t * 256 + j] = h; }
    }
    if (!PASS_C) { CA[(size_t)(tile * 2 + dir) * 256 + j] = ap; CB[(size_t)(tile * 2 + dir) * 256 + j] = h; }
    __syncthreads();
    if (PASS_C) {
        const int lane = tid & 63, wid = tid >> 6; const float* gain = PIN(6) + l * 1024 + 768 + lane * 4;
#pragma unroll 1
        for (int r = 0; r < 4; ++r) { const int t = wid + 8 * r; const size_t row = (size_t)(rowb + t0 + t);
            const f32x4 a = *(const f32x4*)(hs0 + t * 256 + lane * 4), b = *(const f32x4*)(hs1 + t * 256 + lane * 4);
            const u32x2 gw = *(const u32x2*)(ub + row * DIN + 3584 + lane * 4);
            const float gt[4] = {lo16(gw.x), hi16(gw.x), lo16(gw.y), hi16(gw.y)};
            float y[4], ss = 0.f;
#pragma unroll
            for (int e = 0; e < 4; ++e) { const float x = gt[e]; const float ge = 0.5f * x * (1.0f + tanhf(0.7978845608f * (x + 0.044715f * x * x * x))); y[e] = (a[e] + b[e]) * ge; ss += y[e] * y[e]; }
            ss = wave_sum(ss);
            const float rstd = rsqrtf(ss * (1.0f / 256.0f) + EPSN);
            u32x2 o; o.x = pk2(y[0] * rstd * gain[0], y[1] * rstd * gain[1]); o.y = pk2(y[2] * rstd * gain[2], y[3] * rstd * gain[3]);
            *(u32x2*)(yb + row * DM + 768 + lane * 4) = o; }
        __syncthreads();
    }
}
struct RgW { float ba, bx, sp; };
#define RG_LOAD_W(p, l, tid, wA, wX, rw) do { const int dir_ = (tid) >> 8, j_ = (tid) & 255, head_ = j_ >> 6, jj_ = j_ & 63; \
        const float* pa_ = PIN(26) + (size_t)((((l) * 2 + dir_) * 4 + head_) * 64) * 64 + jj_; const float* px_ = PIN(28) + (size_t)((((l) * 2 + dir_) * 4 + head_) * 64) * 64 + jj_; \
        _Pragma("unroll") for (int i_ = 0; i_ < 64; ++i_) { wA[i_] = pa_[i_ * 64]; wX[i_] = px_[i_ * 64]; } \
        rw.ba = PIN(27)[((l) * 2 + dir_) * 256 + j_]; rw.bx = PIN(29)[((l) * 2 + dir_) * 256 + j_]; rw.sp = log1pf(expf(-PIN(30)[((l) * 2 + dir_) * 256 + j_])); } while (0)
__device__ __forceinline__ void rg_carry(const P& p, int b, int L) {
    int tid_ = threadIdx.x; asm volatile("" : "+v"(tid_)); OPQ_Z const int tid = tid_, dir = tid >> 8, j = tid & 255, ntl = L >> 5, tb = b * ntl;
    const float* __restrict__ CA = (const float*)(PWS + WS_RGC); const float* __restrict__ CB = CA + 524288; float* __restrict__ CIN = (float*)(PWS + WS_RGC) + 2 * 524288;
    float H = 0.f;
#pragma unroll 1
    for (int k0 = 0; k0 < ntl; k0 += 8) {
        float a[8], bb[8];
#pragma unroll
        for (int i = 0; i < 8; ++i) { const int k = dir ? ntl - 1 - (k0 + i) : k0 + i; const size_t idx = (size_t)((tb + k) * 2 + dir) * 256 + j; a[i] = CA[idx]; bb[i] = CB[idx]; }
#pragma unroll
        for (int i = 0; i < 8; ++i) { const int k = dir ? ntl - 1 - (k0 + i) : k0 + i; const size_t idx = (size_t)((tb + k) * 2 + dir) * 256 + j; CIN[idx] = H; H = a[i] * H + bb[i]; }
    }
}

__device__ __forceinline__ void prep_phase(const P& p, unsigned char* lds, int l, int B, int L) {
    int tid_ = threadIdx.x; asm volatile("" : "+v"(tid_)); OPQ_Z const int tid = tid_, G = gridDim.x;
    float wA[64], wX[64]; RgW rw; RG_LOAD_W(p, l, tid, wA, wX, rw);
    const bf16_t* __restrict__ ub = (const bf16_t*)(PWS + WS_U); bf16_t* __restrict__ vT = (bf16_t*)(PWS + WS_VT);
    bf16_t* sm = (bf16_t*)lds;
    const float* cw = PIN(12) + l * 3 * 768; const float* cb = PIN(13) + l * 768;
#pragma unroll 1
    for (int tile = blockIdx.x; tile < MH / 64; tile += G) {
        const int r0 = tile * 64, rowb = (r0 / L) * L, t0 = r0 - rowb;
        {
            const int c = tid & 255;
            const float b1 = cb[256 + c], b2 = cb[512 + c];
            const float w10 = cw[256 + c], w11 = cw[768 + 256 + c], w12 = cw[1536 + 256 + c], w20 = cw[512 + c], w21 = cw[768 + 512 + c], w22 = cw[1536 + 512 + c];
#pragma unroll 2
            for (int r = 0; r < 32; ++r) { const int t = (tid >> 8) + 2 * r, tok = t0 + t;
                const bf16_t* up = ub + (size_t)(r0 + t) * DIN + c;
                float x1 = b1 + w11 * bf2f(up[256]), vv = b2 + w21 * bf2f(up[512]);
                if (tok > 0) { x1 += w10 * bf2f(up[256 - DIN]); vv += w20 * bf2f(up[512 - DIN]); }
                if (tok + 1 < L) { x1 += w12 * bf2f(up[256 + DIN]); vv += w22 * bf2f(up[512 + DIN]); }
                sm[c * 66 + t] = f2bf(vv * x1); }
        }
        __syncthreads();
        for (int e = tid; e < 256 * 64; e += 512) { const int c = e >> 6, t = e & 63; vT[(size_t)c * MH + r0 + t] = sm[c * 66 + t]; }
        __syncthreads();
#pragma unroll 1
        for (int sub = 0; sub < 2; ++sub) rg_tile<false>(p, lds, l, rowb, L, t0 + 32 * sub, ub, nullptr, wA, wX, rw.ba, rw.bx, rw.sp, tid);
    }
}

__device__ __forceinline__ void hy_conv_naive(const P& p, unsigned char* lds, int B, int L) {
    int tid_ = threadIdx.x; asm volatile("" : "+v"(tid_)); OPQ_Z const int tid = tid_, G = gridDim.x;
    const bf16_t* __restrict__ vT = (const bf16_t*)(PWS + WS_VT); const bf16_t* __restrict__ Gf = (const bf16_t*)(PWS + WS_G); float* __restrict__ yT = (float*)(PWS + WS_YT);
    bf16_t* vs = (bf16_t*)lds; bf16_t* gs = vs + 16384;
#pragma unroll 1
    for (int it = blockIdx.x; it < 256 * B; it += G) { const int c = it / B, b = it % B;
        for (int e = tid; e < L; e += 512) vs[e] = vT[(size_t)c * MH + b * L + e];
        for (int e = tid; e < 2 * L + 64; e += 512) gs[e] = Gf[(size_t)c * GLEN + e];
        __syncthreads();
#pragma unroll 1
        for (int t = tid; t < L; t += 512) { float acc = 0.f; const bf16_t* gp = gs + 32 + L - t;
            for (int s = 0; s < L; ++s) acc += bf2f(gp[s]) * bf2f(vs[s]);
            yT[(size_t)c * MH + b * L + t] = acc; }
        __syncthreads();
    }
}

__device__ __forceinline__ void hg_chain_naive(const P& p, unsigned char* lds, int l, int b, int h, int dir, int L) {
    int tid_ = threadIdx.x; asm volatile("" : "+v"(tid_)); OPQ_Z const int tid = tid_, dv = tid & 127, kq = __builtin_amdgcn_readfirstlane(tid >> 7);
    const bf16_t* __restrict__ ub = (const bf16_t*)(PWS + WS_U); bf16_t* __restrict__ ob = (bf16_t*)(PWS + (dir ? WS_OB : WS_OF));
    float* fs = (float*)lds; float* ks = fs + 128; float* qs = ks + 128; float* op = qs + 128;
    const float lbv = ((const float*)(PWS + WS_LB))[(dir * 2 + l) * 512 + h * 128 + dv];
    float S[32];
#pragma unroll
    for (int i = 0; i < 32; ++i) S[i] = 0.f;
    const int zoff = (dir ? 2304 : 1792) + h * 128 + dv, qoff = 768 + h * 128 + dv, voff = 1280 + h * 128 + dv;
    size_t row = (size_t)b * L + (dir ? L - 1 : 0);
    bf16_t zn = ub[row * DIN + zoff], qn = ub[row * DIN + qoff], vn = ub[row * DIN + voff];
#pragma unroll 1
    for (int step = 0; step < L; ++step) {
        const size_t crow = row; const float z = bf2f(zn), q = bf2f(qn), v = bf2f(vn);
        if (step + 1 < L) { row = dir ? row - 1 : row + 1; zn = ub[row * DIN + zoff]; qn = ub[row * DIN + qoff]; vn = ub[row * DIN + voff]; }
        if (tid < 128) { const float sg = sigm(z); fs[tid] = lbv + (1.0f - lbv) * sg; ks[tid] = (1.0f - lbv) * (1.0f - sg); qs[tid] = q; }
        __syncthreads();
        float o = 0.f;
#pragma unroll
        for (int i = 0; i < 32; ++i) { const int k = kq * 32 + i; S[i] = fs[k] * S[i] + ks[k] * v; o += S[i] * qs[k]; }
        op[kq * 128 + dv] = o;
        __syncthreads();
        if (tid < 128) ob[crow * 512 + h * 128 + tid] = f2bf(op[tid] + op[128 + tid] + op[256 + tid] + op[384 + tid]);
    }
    __syncthreads();
}

__device__ __forceinline__ void mix_phase(const P& p, unsigned char* lds, int l, int B, int L) {
    const int G = gridDim.x, bid = blockIdx.x;
    if (bid >= G - B) rg_carry(p, G - 1 - bid, L);
#pragma unroll 1
    for (int it = bid; it < B * 8; it += G) hg_chain_naive(p, lds, l, it >> 3, (it >> 1) & 3, it & 1, L);
    hy_conv_naive(p, lds, B, L);
}

__device__ __forceinline__ void post_phase(const P& p, unsigned char* lds, int l, int B, int L) {
    int tid_ = threadIdx.x; asm volatile("" : "+v"(tid_)); OPQ_Z const int tid = tid_, lane = tid & 63, wid = tid >> 6, G = gridDim.x;
    const bf16_t* __restrict__ ub = (const bf16_t*)(PWS + WS_U); const float* __restrict__ yT = (const float*)(PWS + WS_YT);
    const bf16_t* __restrict__ of = (const bf16_t*)(PWS + WS_OF); const bf16_t* __restrict__ obk = (const bf16_t*)(PWS + WS_OB);
    bf16_t* __restrict__ yb = (bf16_t*)(PWS + WS_H);
    float* sy = (float*)lds;
    const float* cw = PIN(12) + l * 3 * 768; const float* cb = PIN(13) + l * 768; const float* hbias = PIN(22) + l * 256; const float* gain = PIN(6) + l * 1024;
#pragma unroll 1
    for (int tile = blockIdx.x; tile < MH / 64; tile += G) {
        const int r0 = tile * 64, rowb = (r0 / L) * L, t0 = r0 - rowb;
        for (int e = tid; e < 256 * 64; e += 512) { const int c = e >> 6, t = e & 63; sy[t * 257 + c] = yT[(size_t)c * MH + r0 + t]; }
        __syncthreads();
#pragma unroll 1
        for (int r = 0; r < 8; ++r) { const int t = wid + 8 * r, tok = t0 + t; const size_t row = (size_t)(r0 + t);
            float y[4], ss = 0.f;
#pragma unroll
            for (int e = 0; e < 4; ++e) { const int c = lane * 4 + e; float cv[3];
#pragma unroll
                for (int g = 0; g < 3; ++g) { const int col = g * 256 + c; const bf16_t* up = ub + row * DIN + col; float a = cb[col] + cw[768 + col] * bf2f(up[0]);
                    if (tok > 0) a += cw[col] * bf2f(up[-DIN]);
                    if (tok + 1 < L) a += cw[1536 + col] * bf2f(up[DIN]);
                    cv[g] = a; }
                const float v = cv[2] * cv[1];
                y[e] = (sy[t * 257 + c] + v * hbias[c]) * cv[0]; ss += y[e] * y[e]; }
            ss = wave_sum(ss);
            { const float rstd = rsqrtf(ss * (1.0f / 256.0f) + EPSN); u32x2 o; o.x = pk2(y[0] * rstd * gain[lane * 4], y[1] * rstd * gain[lane * 4 + 1]); o.y = pk2(y[2] * rstd * gain[lane * 4 + 2], y[3] * rstd * gain[lane * 4 + 3]);
              *(u32x2*)(yb + row * DM + lane * 4) = o; }
            { const u32x4 a = *(const u32x4*)(of + row * 512 + lane * 8), b = *(const u32x4*)(obk + row * 512 + lane * 8), gw = *(const u32x4*)(ub + row * DIN + 2816 + lane * 8);
              float o8[8] = {lo16(a.x) + lo16(b.x), hi16(a.x) + hi16(b.x), lo16(a.y) + lo16(b.y), hi16(a.y) + hi16(b.y), lo16(a.z) + lo16(b.z), hi16(a.z) + hi16(b.z), lo16(a.w) + lo16(b.w), hi16(a.w) + hi16(b.w)};
              const float g8[8] = {lo16(gw.x), hi16(gw.x), lo16(gw.y), hi16(gw.y), lo16(gw.z), hi16(gw.z), lo16(gw.w), hi16(gw.w)};
              float s2 = 0.f;
#pragma unroll
              for (int e = 0; e < 8; ++e) s2 += o8[e] * o8[e];
              s2 += __shfl_xor(s2, 1); s2 += __shfl_xor(s2, 2); s2 += __shfl_xor(s2, 4); s2 += __shfl_xor(s2, 8);
              const float rstd = rsqrtf(s2 * (1.0f / 128.0f) + EPSN); const float* gn = gain + 256 + lane * 8;
#pragma unroll
              for (int e = 0; e < 8; ++e) { const float gg = g8[e]; o8[e] = o8[e] * rstd * gn[e] * (gg * sigm(gg)); }
              u32x4 o; o.x = pk2(o8[0], o8[1]); o.y = pk2(o8[2], o8[3]); o.z = pk2(o8[4], o8[5]); o.w = pk2(o8[6], o8[7]);
              *(u32x4*)(yb + row * DM + 256 + lane * 8) = o; }
        }
        __syncthreads();
    }
    int tid2_ = threadIdx.x; asm volatile("" : "+v"(tid2_)); const int tid2 = tid2_;
    float wA[64], wX[64]; RgW rw; RG_LOAD_W(p, l, tid2, wA, wX, rw);
#pragma unroll 1
    for (int tile = blockIdx.x; tile < MH / 32; tile += G) {
        const int r0 = tile * 32, rowb = (r0 / L) * L, t0 = r0 - rowb;
        rg_tile<true>(p, lds, l, rowb, L, t0, ub, yb, wA, wX, rw.ba, rw.bx, rw.sp, tid2);
    }
}

__global__ void __launch_bounds__(512, 2) hymba_fwd(P p) {
    extern __shared__ __attribute__((aligned(16))) unsigned char lds[];
    cg::grid_group grid = cg::this_grid();
    OPQ_Z
    const int G = gridDim.x, bid = blockIdx.x;
    bf16_t* hbuf = (bf16_t*)(PWS + WS_H); bf16_t* ubuf = (bf16_t*)(PWS + WS_U);
    const float* mod = (const float*)(PWS + WS_MOD);
#ifndef NO_INIT
    init_phase(p, lds);
#endif
    int oK1 = DM, oK2 = DFF, oN1 = DIN, oN2 = DM, oN3 = 2 * DFF, oM = MH;
    asm volatile("" : "+s"(oK1), "+s"(oK2), "+s"(oN1), "+s"(oN2), "+s"(oN3), "+s"(oM));
    grid.sync();
#pragma unroll 1
    for (int half = 0; half < 2; ++half) {
        const int B = half ? 2 : 8, L = half ? 16384 : 4096, lshift = half ? 14 : 12, rbase = half ? 8 : 0;
        const float* xin = PIN(half); float* xres = POUT + (size_t)half * MH * DM;
#pragma unroll 1
        for (int l = 0; l < 2; ++l) {
            const float* xcur = l == 0 ? xin : xres;
            const float* modl = mod + (size_t)l * 10 * 6144;
#ifndef NO_NORM
            norm_mod(xcur, PIN(9) + l * DM, modl, 1024, 0, rbase, lshift, hbuf);
#endif
#ifndef NO_FILT
            filter_gen(p, lds, l, L);
#endif
            grid.sync();
#ifndef NO_G1
            { pg8::Gemm g{hbuf, (const bf16_t*)(PWS + WS_WIN) + (size_t)l * DIN * DM, oM, oN1, oK1}; pg8::StaticOrder S; S.init(oM, oN1, G, bid); EpiB16 E{ubuf, DIN};
              pg8::gemm_phase<EpiB16, pg8::StaticOrder>((LDSP unsigned char*)lds, g, S, E, nullptr); }
#endif
            grid.sync();
#ifndef NO_PREP
            prep_phase(p, lds, l, B, L);
#endif
            grid.sync();
#ifndef NO_MIX
            mix_phase(p, lds, l, B, L);
#endif
            grid.sync();
#ifndef NO_POST
            post_phase(p, lds, l, B, L);
#endif
            grid.sync();
#ifndef NO_G2
            { pg8::Gemm g{hbuf, (const bf16_t*)(PWS + WS_WOUT) + (size_t)l * DM * DM, oM, oN2, oK1}; pg8::StaticOrder S; S.init(oM, oN2, G, bid); EpiRes E{xcur, xres, modl + (size_t)rbase * 6144 + 2048, lshift};
              pg8::gemm_phase<EpiRes, pg8::StaticOrder>((LDSP unsigned char*)lds, g, S, E, nullptr); }
#endif
            grid.sync();
            norm_mod(xres, PIN(10) + l * DM, modl, 4096, 3072, rbase, lshift, hbuf);
            grid.sync();
#ifndef NO_G3
            { pg8::Gemm g{hbuf, (const bf16_t*)(PWS + WS_WGU) + (size_t)l * 2 * DFF * DM, oM, oN3, oK1}; pg8::StaticOrder S; S.init(oM, oN3, G, bid); EpiSwi E{ubuf};
              pg8::gemm_phase<EpiSwi, pg8::StaticOrder>((LDSP unsigned char*)lds, g, S, E, nullptr); }
#endif
            grid.sync();
#ifndef NO_G4
            { pg8::Gemm g{ubuf, (const bf16_t*)(PWS + WS_WD) + (size_t)l * DM * DFF, oM, oN2, oK2}; pg8::StaticOrder S; S.init(oM, oN2, G, bid); EpiRes E{xres, xres, modl + (size_t)rbase * 6144 + 5120, lshift};
              pg8::gemm_phase<EpiRes, pg8::StaticOrder>((LDSP unsigned char*)lds, g, S, E, nullptr); }
#endif
            grid.sync();
        }
        final_norm(xres, PIN(11));
    }
}

extern "C" void kernel_launch(void* const* d_in, const int* in_sizes, int n_in, void* d_out, int out_size, void* d_ws, size_t ws_size, hipStream_t stream) {
    static int grid = 0;
    if (grid == 0) {
        int dev = 0, cus = 0, per_cu = 0;
        hipGetDevice(&dev); hipDeviceGetAttribute(&cus, hipDeviceAttributeMultiprocessorCount, dev);
        hipFuncSetAttribute((const void*)hymba_fwd, hipFuncAttributeMaxDynamicSharedMemorySize, LDS_BYTES);
        hipOccupancyMaxActiveBlocksPerMultiprocessor(&per_cu, (const void*)hymba_fwd, 512, LDS_BYTES);
        if (per_cu < 1) per_cu = 1;
        grid = cus * per_cu;
        if (n_in != 34 || ws_size < WS_END) { fprintf(stderr, "kernel_launch: unexpected n_in %d / ws %zu\n", n_in, ws_size); }
    }
    P p{};
    for (int i = 0; i < 34; ++i) p.ptr[i] = d_in[i];
    p.ptr[34] = d_out; p.ptr[35] = d_ws;
    void* args[] = {&p};
    hipError_t e = hipLaunchCooperativeKernel((const void*)hymba_fwd, dim3(grid), dim3(512), args, LDS_BYTES, stream);
    if (e != hipSuccess) fprintf(stderr, "cooperative launch failed: %s (grid %d)\n", hipGetErrorString(e), grid);
}
```

```cpp
#include <hip/hip_runtime.h>
#include <hip/hip_cooperative_groups.h>
#include <cstdio>
namespace cg = cooperative_groups;
namespace pg8 {
#define PG8_LAS __attribute__((address_space(3)))
typedef unsigned short bf16_t;
typedef short bf16x8 __attribute__((ext_vector_type(8)));
typedef float f32x4 __attribute__((ext_vector_type(4)));
typedef unsigned u32x4 __attribute__((ext_vector_type(4)));
constexpr int BM = 256, BK = 64, HALF = 128, HTB = HALF * BK * 2  , STAGE_BYTES = 8 * HTB, NXCD = 8, WGM = 8;

__host__ __device__ __forceinline__ int lds_byte(int r, int c) { const int st = (r >> 4) * 2 + (c >> 5), rr = r & 15, cc = c & 31, ob = rr * 64 + cc * 2; return st * 1024 + (ob ^ (((ob >> 9) & 1) << 5)); }
__host__ __device__ __forceinline__ void stage_rc(int b, int& R, int& C) { const int st = b / 1024, sb = b % 1024, swz = sb ^ (((sb >> 9) & 1) << 5); R = (st >> 1) * 16 + swz / 64; C = (st & 1) * 32 + (swz % 64) / 2; }
__host__ __device__ __forceinline__ int perm32(int rho) { const int n = rho >> 4, i = rho & 15; return 8 * (i >> 2) + 4 * n + (i & 3); }

struct Unit { int pm, pn; };
struct Gemm { const bf16_t* A; const bf16_t* Bt; int M, N, K; };

struct StaticOrder {
    int nM, nN, nwg, G, c;
    __host__ __device__ void init(int M, int N, int G_, int c_) { nM = M / BM; nN = N / BM; nwg = nM * nN; G = G_; c = c_; }
    __host__ __device__ bool next(int i, Unit& u) const {
        const long L = (long)i * G + c; if (L >= nwg) return false;
        int wgid = (int)L; { const int q = nwg / NXCD, r = nwg % NXCD, xcd = wgid % NXCD, off = wgid / NXCD; wgid = (xcd < r ? xcd * (q + 1) : r * (q + 1) + (xcd - r) * q) + off; }
        const int nig = WGM * nN, gid = wgid / nig, fm = gid * WGM, gsz = (nM - fm) < WGM ? (nM - fm) : WGM;
        u.pm = fm + ((wgid % nig) % gsz); u.pn = (wgid % nig) / gsz; return true;
    }
    __device__ __forceinline__ void a_ready(const Unit&) const {}
    __device__ __forceinline__ void done(const Unit&) const {}
};
__device__ __forceinline__ unsigned cvt_pk_bf16(float lo, float hi) { unsigned r; asm volatile("v_cvt_pk_bf16_f32 %0, %1, %2" : "=v"(r) : "v"(lo), "v"(hi)); return r; }
typedef float f32x2 __attribute__((ext_vector_type(2)));
template <class Epi, class Sched, bool STAMP = false>
__device__ __forceinline__ void gemm_phase(PG8_LAS unsigned char* lds, const Gemm g, const Sched& S, const Epi& E, unsigned long long* stamps) {
    int tid_ = threadIdx.x; asm volatile("" : "+v"(tid_)); const int tid = tid_, wid = __builtin_amdgcn_readfirstlane(tid >> 6), lane = tid & 63, wr = wid >> 2, wc = wid & 3, fr = lane & 15, fq = lane >> 4;
    const int K = g.K, nt = K / BK;
    int ts_lo = 0, ts_hi = 0, nts = 0; const unsigned long long rt_entry = STAMP ? (unsigned long long)wall_clock64() : 0ull;
#define PG8_STAMP() do { if (STAMP && wid == 0 && nts < 64) { const unsigned long long _c = (unsigned long long)clock64(); \
        ts_lo = (lane == nts) ? (int)(unsigned)_c : ts_lo; ts_hi = (lane == nts) ? (int)(unsigned)(_c >> 32) : ts_hi; ++nts; } } while (0)
    PG8_STAMP();
    unsigned voffA[2], voffB[2];
#pragma unroll
    for (int i = 0; i < 2; ++i) { int R, C; stage_rc(tid * 16 + i * 8192, R, C); const int Rb = Epi::PERM ? ((R & ~31) + perm32(R & 31)) : R;
        voffA[i] = (unsigned)(R * K + C) * 2u; voffB[i] = (unsigned)(Rb * K + C) * 2u; }
    const size_t kstep = (size_t)(BK * 2);
    const size_t hstep = (size_t)HALF * K * 2;
    const size_t tstep = 2 * hstep;
    const unsigned ldsw = (unsigned)wid * 1024u;
    const int aoff = lds_byte(wr * 64 + fr, fq * 8), boff = lds_byte(wc * 32 + fr, fq * 8);
#define PG8_SA(b, h) (((b) * 2 + (h)) * HTB)
#define PG8_SB(b, h) ((4 + (b) * 2 + (h)) * HTB)
#define PG8_STAGE(bufoff, gbase, voff) do { _Pragma("unroll") for (int _i = 0; _i < 2; ++_i) \
        __builtin_amdgcn_global_load_lds((const unsigned*)((const char*)(gbase) + (voff)[_i]), (PG8_LAS unsigned*)(lds + (bufoff) + ldsw + _i * 8192), 16, 0, 0); } while (0)
#define PG8_LDA(dst, b, h) do { _Pragma("unroll") for (int m = 0; m < 4; ++m) _Pragma("unroll") for (int k = 0; k < 2; ++k) dst[m][k] = *(const PG8_LAS bf16x8*)(lds + PG8_SA(b, h) + aoff + m * 2048 + k * 1024); } while (0)
#define PG8_LDB(dst, b, h) do { _Pragma("unroll") for (int n = 0; n < 2; ++n) _Pragma("unroll") for (int k = 0; k < 2; ++k) dst[n][k] = *(const PG8_LAS bf16x8*)(lds + PG8_SB(b, h) + boff + n * 2048 + k * 1024); } while (0)
#define PG8_MMA(ai, bj, At, Bt) do { __builtin_amdgcn_s_setprio(1); _Pragma("unroll") for (int m = 0; m < 4; ++m) _Pragma("unroll") for (int n = 0; n < 2; ++n) _Pragma("unroll") for (int k = 0; k < 2; ++k) \
        acc[ai][bj][m][n] = __builtin_amdgcn_mfma_f32_16x16x32_bf16(Bt[n][k], At[m][k], acc[ai][bj][m][n], 0, 0, 0); __builtin_amdgcn_s_setprio(0); } while (0)
#define PG8_WAIT_V(n) asm volatile("s_waitcnt vmcnt(" #n ")" ::: "memory")
#define PG8_WAIT_L(n) asm volatile("s_waitcnt lgkmcnt(" #n ")" ::: "memory")
#define PG8_BAR __builtin_amdgcn_s_barrier()
#define PG8_SCHED __builtin_amdgcn_sched_barrier(0)
    Unit cur, nxt; int ui = 0;
    if (!S.next(0, cur)) return;
    f32x4 acc[2][2][4][2];
#pragma unroll
    for (int a = 0; a < 2; ++a)
#pragma unroll
        for (int b = 0; b < 2; ++b)
#pragma unroll
            for (int m = 0; m < 4; ++m)
#pragma unroll
                for (int n = 0; n < 2; ++n) acc[a][b][m][n] = (f32x4){0.f, 0.f, 0.f, 0.f};
    bf16x8 At[4][2], B0[2][2], B1[2][2];
    const char* cA = (const char*)g.A + (size_t)cur.pm * tstep; const char* cB = (const char*)g.Bt + (size_t)cur.pn * tstep;
    S.a_ready(cur);
    PG8_STAGE(PG8_SB(0, 0), cB, voffB); PG8_STAGE(PG8_SA(0, 0), cA, voffA); PG8_STAGE(PG8_SB(0, 1), cB + hstep, voffB); PG8_STAGE(PG8_SA(0, 1), cA + hstep, voffA);
    if (wr == 1) PG8_BAR;
    PG8_WAIT_V(4); PG8_BAR;
    PG8_STAGE(PG8_SB(1, 0), cB + kstep, voffB); PG8_STAGE(PG8_SA(1, 0), cA + kstep, voffA); PG8_STAGE(PG8_SB(1, 1), cB + hstep + kstep, voffB);
    PG8_WAIT_V(6); PG8_BAR;
    PG8_STAMP();
    for (;;) {
        const bool has_next = S.next(ui + 1, nxt);
        const char* nA = has_next ? (const char*)g.A + (size_t)nxt.pm * tstep : cA; const char* nB = has_next ? (const char*)g.Bt + (size_t)nxt.pn * tstep : cB;
        for (int t = 0; t < nt; t += 2) {
            const bool last = (t == nt - 2);
            const char* a1 = cA + (size_t)(t + 1) * kstep;
            const char* a2 = last ? nA : cA + (size_t)(t + 2) * kstep; const char* b2 = last ? nB : cB + (size_t)(t + 2) * kstep;
            const char* a3 = a2 + kstep; const char* b3 = b2 + kstep;
            if (last && has_next) S.a_ready(nxt);
            PG8_LDB(B0, 0, 0); PG8_SCHED; PG8_LDA(At, 0, 0); PG8_STAGE(PG8_SA(1, 1), a1 + hstep, voffA);
            PG8_WAIT_L(8); PG8_BAR; PG8_WAIT_L(0); PG8_MMA(0, 0, At, B0); PG8_BAR; PG8_SCHED;
            PG8_LDB(B1, 0, 1); PG8_STAGE(PG8_SB(0, 0), b2, voffB);
            PG8_BAR; PG8_WAIT_L(0); PG8_MMA(0, 1, At, B1); PG8_BAR;
            PG8_LDA(At, 0, 1); PG8_STAGE(PG8_SA(0, 0), a2, voffA);
            PG8_BAR; PG8_WAIT_L(0); PG8_MMA(1, 0, At, B0); PG8_BAR; PG8_SCHED;
            PG8_STAGE(PG8_SB(0, 1), b2 + hstep, voffB);
            PG8_WAIT_V(6); PG8_BAR; PG8_MMA(1, 1, At, B1); PG8_BAR;
            PG8_LDB(B0, 1, 0); PG8_SCHED; PG8_LDA(At, 1, 0); PG8_STAGE(PG8_SA(0, 1), a2 + hstep, voffA);
            PG8_WAIT_L(8); PG8_BAR; PG8_WAIT_L(0); PG8_MMA(0, 0, At, B0); PG8_BAR; PG8_SCHED;
            PG8_LDB(B1, 1, 1); PG8_STAGE(PG8_SB(1, 0), b3, voffB);
            PG8_BAR; PG8_WAIT_L(0); PG8_MMA(0, 1, At, B1); PG8_BAR;
            PG8_LDA(At, 1, 1); PG8_STAGE(PG8_SA(1, 0), a3, voffA);
            PG8_BAR; PG8_WAIT_L(0); PG8_MMA(1, 0, At, B0); PG8_BAR; PG8_SCHED;
            PG8_STAGE(PG8_SB(1, 1), b3 + hstep, voffB);
            PG8_WAIT_V(6); PG8_BAR; PG8_MMA(1, 1, At, B1); PG8_BAR;
        }
        PG8_STAMP();
        if constexpr (!Epi::AFTER_DRAIN) { E(acc, cur, wr, wc, fr, fq); S.done(cur); }
        PG8_STAMP();
        if (!has_next) break;
#pragma unroll
        for (int a = 0; a < 2; ++a)
#pragma unroll
            for (int b = 0; b < 2; ++b)
#pragma unroll
                for (int m = 0; m < 4; ++m)
#pragma unroll
                    for (int n = 0; n < 2; ++n) acc[a][b][m][n] = (f32x4){0.f, 0.f, 0.f, 0.f};
        cur = nxt; cA = nA; cB = nB; ++ui;
    }
    PG8_WAIT_V(0);
    if (wr == 0) PG8_BAR;
    PG8_BAR;
    if constexpr (Epi::AFTER_DRAIN) { E.fused(acc, cur, wr, wc, fr, fq, lds, wid, lane); S.done(cur); }
    PG8_STAMP();
    if (STAMP && wid == 0) { stamps[lane] = lane < nts ? (((unsigned long long)(unsigned)ts_hi << 32) | (unsigned)ts_lo) : 0ull;
        if (lane == 62) stamps[62] = rt_entry; if (lane == 63) stamps[63] = (unsigned long long)wall_clock64(); }
#undef PG8_STAMP
#undef PG8_SA
#undef PG8_SB
#undef PG8_STAGE
#undef PG8_LDA
#undef PG8_LDB
#undef PG8_MMA
#undef PG8_WAIT_V
#undef PG8_WAIT_L
#undef PG8_BAR
#undef PG8_SCHED
}
}
#define XB_TMO      128
#define XB_XCNT(j)  (256  + 64 * (j))
#define XB_XSUB(j)  (1280 + 64 * (j))
#define XB_XGEN(j)  (2304 + 64 * (j))
#define XB_TOP      3328
#define XB_TOPGEN   3392
#define XCD_BAR_WORDS 3456
#define XB_SPIN_CAP (1u << 18)
#define LAS __attribute__((address_space(3)))

__device__ __forceinline__ unsigned xb_ld(unsigned* p)              { return __hip_atomic_load(p, __ATOMIC_RELAXED, __HIP_MEMORY_SCOPE_AGENT); }
__device__ __forceinline__ unsigned xb_add(unsigned* p, unsigned v) { return __hip_atomic_fetch_add(p, v, __ATOMIC_RELAXED, __HIP_MEMORY_SCOPE_AGENT); }
__device__ __forceinline__ unsigned xb_xcc_id() { return (unsigned)__builtin_amdgcn_s_getreg((3 << 11) | 20) & 0xFu; }
#define XB_SPIN(cond, bar) do { unsigned _sp = 0; while (cond) { __builtin_amdgcn_s_sleep(1); \
    if ((++_sp & 255u) == 0u) { if (xb_ld(&(bar)[XB_TMO])) break; if (_sp > XB_SPIN_CAP) { atomicAdd(&(bar)[XB_TMO], 1u); break; } } } } while (0)

struct XcdBarrier {
    unsigned* bar; unsigned x;
    volatile LAS unsigned* st;
};

__device__ __forceinline__ XcdBarrier xcd_barrier_post(unsigned* bar, volatile LAS unsigned* st) {
    XcdBarrier b; b.bar = bar; b.x = xb_xcc_id(); b.st = st;
    if (threadIdx.x == 0) (void)xb_add(&bar[XB_XCNT(b.x)], 1u);
    return b;
}
__device__ __forceinline__ void xcd_barrier_complete(unsigned* bar, unsigned x, unsigned& nloc, unsigned& nx) {
    const unsigned G = gridDim.x * gridDim.y * gridDim.z;
    unsigned sum, cnt, mine, sp = 0u;
    for (;;) {
        sum = 0u; cnt = 0u; mine = 0u;
#pragma unroll
        for (unsigned j = 0; j < 16; ++j) { const unsigned c = xb_ld(&bar[XB_XCNT(j)]); sum += c; cnt += (c > 0u) ? 1u : 0u; mine = (j == x) ? c : mine; }
        if (sum == G) break;
        __builtin_amdgcn_s_sleep(1);
        if ((++sp & 255u) == 0u) { if (xb_ld(&bar[XB_TMO])) break; if (sp > XB_SPIN_CAP) { atomicAdd(&bar[XB_TMO], 1u); break; } }
    }
    nloc = mine > 0u ? mine : 1u; nx = cnt > 0u ? cnt : 1u;
}

__device__ __forceinline__ void xcd_barrier(const XcdBarrier& b) {
    asm volatile("s_waitcnt vmcnt(0)" ::: "memory");
    __syncthreads();
    if (threadIdx.x == 0) {
        unsigned* bar = b.bar;
        __builtin_amdgcn_s_waitcnt(0);
        unsigned nloc = b.st[0], nx = b.st[1];
        if (nloc == 0u) { xcd_barrier_complete(bar, b.x, nloc, nx); b.st[0] = nloc; b.st[1] = nx; }
        const unsigned old = xb_add(&bar[XB_XSUB(b.x)], 1u);
        const unsigned gen = old / nloc;
        if (old + 1u == (gen + 1u) * nloc) {
            __builtin_amdgcn_fence(__ATOMIC_RELEASE, "agent");
            asm volatile("s_waitcnt vmcnt(0)" ::: "memory");
            const unsigned og = xb_add(&bar[XB_TOP], 1u);
            const unsigned tg = og / nx;
            if (og + 1u == (tg + 1u) * nx) xb_add(&bar[XB_TOPGEN], 1u);
            else XB_SPIN(xb_ld(&bar[XB_TOPGEN]) == tg, bar);
            __builtin_amdgcn_fence(__ATOMIC_ACQUIRE, "agent");
            xb_add(&bar[XB_XGEN(b.x)], 1u);
            asm volatile("s_waitcnt vmcnt(0)" ::: "memory");
        } else {
            XB_SPIN(xb_ld(&bar[XB_XGEN(b.x)]) == gen, bar);
            __builtin_amdgcn_fence(__ATOMIC_ACQUIRE, "agent");
            asm volatile("s_waitcnt vmcnt(0)" ::: "memory");
        }
    }
    __syncthreads();
}

typedef unsigned short bf16_t;
typedef float f32x4 __attribute__((ext_vector_type(4)));
typedef unsigned u32x4 __attribute__((ext_vector_type(4)));
typedef unsigned u32x2 __attribute__((ext_vector_type(2)));
#define LDSP PG8_LAS

constexpr int DM = 1024, DIN = 3840, DFF = 2816, MH = 32768;
constexpr int GLEN = 2 * 16384 + 64;
constexpr int LDS_BYTES = 150 * 1024;
constexpr size_t WS_WIN = 0, WS_WOUT = 15728640, WS_WGU = 19922944, WS_WD = 42991616, WS_MOD = 54525952, WS_LB = 55017472,
                 WS_RGC = 55025664  , WS_G = 61317120, WS_VT = 78127104, WS_YT = 94904320, WS_OF = 128458752, WS_OB = 162013184,
                 WS_H = 195567616, WS_U = 262676480, WS_END = 514334720;
constexpr float EPSN = 1e-6f;

struct P { const void* ptr[36]; };
#define PIN(i) ((const float*)p.ptr[(i) + z_])
#define PWS ((unsigned char*)p.ptr[35 + z_])
#define POUT ((float*)p.ptr[34 + z_])
#define OPQ_Z int z_ = 0; asm volatile("" : "+s"(z_));

__device__ __forceinline__ int opq_grid() { int g = gridDim.x; asm volatile("" : "+s"(g)); return g; }
__device__ __forceinline__ float bf2f(bf16_t v) { return __uint_as_float(((unsigned)v) << 16); }
__device__ __forceinline__ bf16_t f2bf(float f) { unsigned u = __float_as_uint(f); u += 0x7FFFu + ((u >> 16) & 1u); return (bf16_t)(u >> 16); }
__device__ __forceinline__ unsigned pk2_sw(float lo, float hi) { return (unsigned)f2bf(lo) | ((unsigned)f2bf(hi) << 16); }
__device__ __forceinline__ unsigned pk2(float lo, float hi) { unsigned r; asm volatile("v_cvt_pk_bf16_f32 %0, %1, %2" : "=v"(r) : "v"(lo), "v"(hi)); return r; }
__device__ __forceinline__ float lo16(unsigned w) { return __uint_as_float(w << 16); }
__device__ __forceinline__ float hi16(unsigned w) { return __uint_as_float(w & 0xffff0000u); }
__device__ __forceinline__ float sigm(float x) { return __builtin_amdgcn_rcpf(1.0f + __expf(-x)); }
__device__ __forceinline__ float wave_sum(float v) {
#pragma unroll
    for (int o = 32; o >= 1; o >>= 1) v += __shfl_xor(v, o);
    return v;
}

struct EpiRes {
    static constexpr bool PERM = false, AFTER_DRAIN = false;
    const float* base; float* out; const float* gate; int lshift;
    __device__ __forceinline__ void operator()(const f32x4 (&acc)[2][2][4][2], const pg8::Unit& u, int wr, int wc, int fr, int fq) const {
        const int row0 = u.pm * 256 + wr * 64 + fr, col0 = u.pn * 256 + wc * 32 + 4 * fq;
        const float* g = gate + (size_t)((u.pm * 256) >> lshift) * 6144 + col0;
        f32x4 gv[2][2];
#pragma unroll
        for (int bj = 0; bj < 2; ++bj)
#pragma unroll
            for (int n = 0; n < 2; ++n) gv[bj][n] = *(const f32x4*)(g + bj * 128 + n * 16);
#pragma unroll
        for (int ai = 0; ai < 2; ++ai)
#pragma unroll
            for (int mp = 0; mp < 2; ++mp) {
                f32x4 bs[2][2][2];
#pragma unroll
                for (int mm = 0; mm < 2; ++mm) { const size_t off = (size_t)(row0 + ai * 128 + (2 * mp + mm) * 16) * DM + col0;
#pragma unroll
                    for (int bj = 0; bj < 2; ++bj)
#pragma unroll
                        for (int n = 0; n < 2; ++n) bs[mm][bj][n] = *(const f32x4*)(base + off + bj * 128 + n * 16); }
#pragma unroll
                for (int mm = 0; mm < 2; ++mm) { const size_t off = (size_t)(row0 + ai * 128 + (2 * mp + mm) * 16) * DM + col0;
#pragma unroll
                    for (int bj = 0; bj < 2; ++bj)
#pragma unroll
                        for (int n = 0; n < 2; ++n) *(f32x4*)(out + off + bj * 128 + n * 16) = bs[mm][bj][n] + gv[bj][n] * acc[ai][bj][2 * mp + mm][n]; }
                asm volatile("" ::: "memory"); }
    }
};
struct EpiSwi {
    static constexpr bool PERM = true, AFTER_DRAIN = false;
    bf16_t* O;
    __device__ __forceinline__ void operator()(const f32x4 (&acc)[2][2][4][2], const pg8::Unit& u, int wr, int wc, int fr, int fq) const {
        const int row0 = u.pm * 256 + wr * 64 + fr, col0 = u.pn * 128 + wc * 32 + 8 * fq;
#pragma unroll
        for (int ai = 0; ai < 2; ++ai)
#pragma unroll
            for (int m = 0; m < 4; ++m) { bf16_t* rowp = O + (size_t)(row0 + ai * 128 + m * 16) * DFF + col0;
                float r[8];
#pragma unroll
                for (int n = 0; n < 2; ++n)
#pragma unroll
                    for (int j = 0; j < 4; ++j) { const float gt = acc[ai][0][m][n][j], up = acc[ai][1][m][n][j]; r[n * 4 + j] = gt * __builtin_amdgcn_rcpf(1.0f + __expf(-gt)) * up; }
                u32x4 w; w.x = pg8::cvt_pk_bf16(r[0], r[1]); w.y = pg8::cvt_pk_bf16(r[2], r[3]); w.z = pg8::cvt_pk_bf16(r[4], r[5]); w.w = pg8::cvt_pk_bf16(r[6], r[7]);
                *(u32x4*)rowp = w; }
    }
};
struct EpiB16 {
    static constexpr bool PERM = true, AFTER_DRAIN = false;
    bf16_t* O; int ldc;
    __device__ __forceinline__ void operator()(const f32x4 (&acc)[2][2][4][2], const pg8::Unit& u, int wr, int wc, int fr, int fq) const {
        const int row0 = u.pm * 256 + wr * 64 + fr, col0 = u.pn * 256 + wc * 32 + 8 * fq;
        float one = 1.0f; asm volatile("" : "+v"(one));
#pragma unroll
        for (int ai = 0; ai < 2; ++ai)
#pragma unroll
            for (int m = 0; m < 4; ++m) { bf16_t* rowp = O + (size_t)(row0 + ai * 128 + m * 16) * ldc + col0;
#pragma unroll
                for (int bj = 0; bj < 2; ++bj) { const f32x4 v0 = acc[ai][bj][m][0] * one, v1 = acc[ai][bj][m][1] * one;
                    u32x4 w; w.x = pg8::cvt_pk_bf16(v0[0], v0[1]); w.y = pg8::cvt_pk_bf16(v0[2], v0[3]); w.z = pg8::cvt_pk_bf16(v1[0], v1[1]); w.w = pg8::cvt_pk_bf16(v1[2], v1[3]);
                    *(u32x4*)(rowp + bj * 128) = w; } }
    }
};

__device__ __forceinline__ void tr_tile(const float* __restrict__ src, bf16_t* __restrict__ dst, int K, int N, int tk, int tn, int gu, float* sm) {
    int tid_ = threadIdx.x; asm volatile("" : "+v"(tid_)); OPQ_Z const int k0 = tk * 64, n0 = tn * 64, tid = tid_;
    for (int e = tid; e < 4096; e += 512) { const int r = e >> 6, c = e & 63; sm[r * 65 + c] = src[(size_t)(k0 + r) * N + n0 + c]; }
    __syncthreads();
    for (int e = tid; e < 4096; e += 512) { const int n = e >> 6, k = e & 63, nn = n0 + n;
        const int drow = gu == 0 ? nn : ((nn >> 7) * 256 + (gu == 2 ? 128 : 0) + (nn & 127));
        dst[(size_t)drow * K + k0 + k] = f2bf(sm[k * 65 + n]); }
    __syncthreads();
}
__device__ __forceinline__ void init_phase(const P& p, unsigned char* lds) {
    float* sm = (float*)lds;
    int tid_ = threadIdx.x; asm volatile("" : "+v"(tid_)); OPQ_Z const int tid = tid_, G = opq_grid(), bid = blockIdx.x;
    bf16_t* win = (bf16_t*)(PWS + WS_WIN); bf16_t* wout = (bf16_t*)(PWS + WS_WOUT); bf16_t* wgu = (bf16_t*)(PWS + WS_WGU); bf16_t* wd = (bf16_t*)(PWS + WS_WD);
    float* mod = (float*)(PWS + WS_MOD); float* lb = (float*)(PWS + WS_LB);
#pragma unroll 1
    for (int it = bid; it < 2 * 3328; it += G) {
        const int l = it / 3328, r = it % 3328;
        const float* src; bf16_t* dst; int K, N, gu = 0, tl;
        if (r < 960) { src = PIN(4) + (size_t)l * 1024 * 3840; dst = win + (size_t)l * 3840 * 1024; K = 1024; N = 3840; tl = r; }
        else if (r < 1216) { src = PIN(5) + (size_t)l * 1024 * 1024; dst = wout + (size_t)l * 1024 * 1024; K = 1024; N = 1024; tl = r - 960; }
        else if (r < 1920) { src = PIN(31) + (size_t)l * 1024 * 2816; dst = wgu + (size_t)l * 5632 * 1024; K = 1024; N = 2816; gu = 1; tl = r - 1216; }
        else if (r < 2624) { src = PIN(32) + (size_t)l * 1024 * 2816; dst = wgu + (size_t)l * 5632 * 1024; K = 1024; N = 2816; gu = 2; tl = r - 1920; }
        else { src = PIN(33) + (size_t)l * 2816 * 1024; dst = wd + (size_t)l * 1024 * 2816; K = 2816; N = 1024; tl = r - 2624; }
        const int ntn = N / 64;
        tr_tile(src, dst, K, N, tl / ntn, tl % ntn, gu, sm);
    }
    for (int e = tid; e < 10240; e += 512) { const int r = e >> 10, k = e & 1023; const float c = r < 8 ? PIN(2)[r * 1024 + k] : PIN(3)[(r - 8) * 1024 + k]; sm[e] = c * sigm(c); }
    __syncthreads();
    float* red = sm + 10240;
#pragma unroll 1
    for (int it = bid; it < 384; it += G) {
        const int l = it / 192, cgp = it % 192, cl = tid & 31, ks = tid >> 5;
        float acc[10];
#pragma unroll
        for (int r = 0; r < 10; ++r) acc[r] = 0.f;
        const float* w = PIN(7) + (size_t)l * 1024 * 6144 + cgp * 32 + cl;
        for (int i = 0; i < 64; ++i) { const int k = ks * 64 + i; const float wv = w[(size_t)k * 6144];
#pragma unroll
            for (int r = 0; r < 10; ++r) acc[r] += sm[r * 1024 + k] * wv; }
#pragma unroll
        for (int r = 0; r < 10; ++r) red[(ks * 10 + r) * 32 + cl] = acc[r];
        __syncthreads();
        if (tid < 320) { const int r = tid >> 5; float s = 0.f; for (int k2 = 0; k2 < 16; ++k2) s += red[(k2 * 10 + r) * 32 + cl];
            mod[(size_t)(l * 10 + r) * 6144 + cgp * 32 + cl] = s + PIN(8)[l * 6144 + cgp * 32 + cl]; }
        __syncthreads();
    }
    if (bid == G - 1) for (int e = tid; e < 1024; e += 512) { const int d = e >> 9, j = e & 511; const float x0 = PIN(23)[(d * 2 + 0) * 512 + j], x1 = PIN(23)[(d * 2 + 1) * 512 + j];
        const float m = fmaxf(x0, x1), e0 = __expf(x0 - m), e1 = __expf(x1 - m); lb[(d * 2 + 0) * 512 + j] = 0.f; lb[(d * 2 + 1) * 512 + j] = e1 / (e0 + e1); }
}

__device__ __forceinline__ void filter_gen(const P& p, unsigned char* lds, int l, int L) {
    float* zf = (float*)lds; float* ha = zf + 64 * 33; float* hb = ha + 64 * 65;
    int tid_ = threadIdx.x; asm volatile("" : "+v"(tid_)); OPQ_Z const int tid = tid_, G = opq_grid(), bid = blockIdx.x;
    bf16_t* Gf = (bf16_t*)(PWS + WS_G);
    const float* w1 = PIN(14) + l * 33 * 64; const float* b1 = PIN(15) + l * 64; const float* w2 = PIN(16) + l * 4096; const float* b2 = PIN(17) + l * 64;
    const float* w3 = PIN(18) + l * 4096; const float* b3 = PIN(19) + l * 64; const float* w4 = PIN(20) + l * 64 * 512; const float* fr_ = PIN(21) + l * 64;
    for (int e = bid * 512 + tid; e < 256 * 65; e += G * 512) { const int ch = e / 65, q = e % 65; const int idx = q < 33 ? q : 32 + 2 * L + (q - 33); Gf[(size_t)ch * GLEN + idx] = 0; }
    const int pos = tid & 63, jg = __builtin_amdgcn_readfirstlane(tid >> 6), lane = tid & 63, fr = lane & 15, fq = lane >> 4;
    const float d_lo = -4.605170186f / 1.5f, d_hi = -4.605170186f / 0.3f;
    bf16_t* h3b = (bf16_t*)(hb + 64 * 65);
    pg8::bf16x8 Bw[4][2];
#pragma unroll
    for (int nb = 0; nb < 4; ++nb)
#pragma unroll
        for (int ks = 0; ks < 2; ++ks)
#pragma unroll
            for (int e2 = 0; e2 < 8; ++e2) Bw[nb][ks][e2] = (short)f2bf(w4[(32 * ks + 8 * fq + e2) * 512 + 64 * jg + 16 * nb + fr]);
#pragma unroll 1
    for (int tile = bid; tile < L / 64; tile += G) {
        const int n0 = tile * 64;
        for (int e = tid; e < 64 * 33; e += 512) { const int ps = e / 33, i = e % 33; const float n = (float)(n0 + ps); float val;
            if (i == 0) val = n / (float)(L - 1);
            else { const int bnd = (i - 1) & 15; const float fb = 1e-4f + (float)bnd * ((15.0f - 1e-4f) / 15.0f); const float ang = (fb * n) * (6.283185307179586f / (float)L); val = (i <= 16) ? __cosf(ang) : -__sinf(ang); }
            zf[ps * 33 + i] = val; }
        __syncthreads();
        {
            float s[8];
#pragma unroll
            for (int jj = 0; jj < 8; ++jj) s[jj] = b1[jg * 8 + jj];
#pragma unroll 3
            for (int i = 0; i < 33; ++i) { const float hv = zf[pos * 33 + i]; const float* wr = w1 + i * 64 + jg * 8;
#pragma unroll
                for (int jj = 0; jj < 8; ++jj) s[jj] += hv * wr[jj]; }
#pragma unroll
            for (int jj = 0; jj < 8; ++jj) ha[pos * 65 + jg * 8 + jj] = __sinf(fr_[jg * 8 + jj] * s[jj]);
        }
        __syncthreads();
        {
            float s[8];
#pragma unroll
            for (int jj = 0; jj < 8; ++jj) s[jj] = b2[jg * 8 + jj];
#pragma unroll 4
            for (int i = 0; i < 64; ++i) { const float hv = ha[pos * 65 + i]; const float* wr = w2 + i * 64 + jg * 8;
#pragma unroll
                for (int jj = 0; jj < 8; ++jj) s[jj] += hv * wr[jj]; }
#pragma unroll
            for (int jj = 0; jj < 8; ++jj) hb[pos * 65 + jg * 8 + jj] = __sinf(fr_[jg * 8 + jj] * s[jj]);
        }
        __syncthreads();
        {
            float s[8];
#pragma unroll
            for (int jj = 0; jj < 8; ++jj) s[jj] = b3[jg * 8 + jj];
#pragma unroll 4
            for (int i = 0; i < 64; ++i) { const float hv = hb[pos * 65 + i]; const float* wr = w3 + i * 64 + jg * 8;
#pragma unroll
                for (int jj = 0; jj < 8; ++jj) s[jj] += hv * wr[jj]; }
#pragma unroll
            for (int jj = 0; jj < 8; ++jj) h3b[pos * 72 + jg * 8 + jj] = f2bf(__sinf(fr_[jg * 8 + jj] * s[jj]));
        }
        __syncthreads();
        f32x4 acc[4][4];
#pragma unroll
        for (int mb = 0; mb < 4; ++mb)
#pragma unroll
            for (int nb = 0; nb < 4; ++nb) acc[mb][nb] = (f32x4){0.f, 0.f, 0.f, 0.f};
#pragma unroll
        for (int mb = 0; mb < 4; ++mb)
#pragma unroll
            for (int ks = 0; ks < 2; ++ks) { const pg8::bf16x8 av = *(const pg8::bf16x8*)(h3b + (16 * mb + fr) * 72 + 32 * ks + 8 * fq);
#pragma unroll
                for (int nb = 0; nb < 4; ++nb) acc[mb][nb] = __builtin_amdgcn_mfma_f32_16x16x32_bf16(av, Bw[nb][ks], acc[mb][nb], 0, 0, 0); }
#pragma unroll
        for (int nb = 0; nb < 4; ++nb) { const int c2 = 64 * jg + 16 * nb + fr, ch = c2 & 255; const float delta = fabsf(d_lo + (float)ch * ((d_hi - d_lo) / 255.0f));
            bf16_t* grow = Gf + (size_t)ch * GLEN + 32 + L;
#pragma unroll
            for (int mb = 0; mb < 4; ++mb)
#pragma unroll
                for (int j = 0; j < 4; ++j) { const int n = n0 + 16 * mb + 4 * fq + j; const float tpos = (float)n / (float)(L - 1);
                    const float val = acc[mb][nb][j] * __expf(-tpos * delta);
                    if (c2 < 256) grow[-n] = f2bf(val); else if (n > 0) grow[n] = f2bf(val); } }
        __syncthreads();
    }
}

__device__ __forceinline__ void norm_mod(const float* x, const float* w, const float* modl, int sc_off, int sh_off, int rbase, int lshift, bf16_t* hb) {
    constexpr int NR = 4;
    int tid_ = threadIdx.x; asm volatile("" : "+v"(tid_)); OPQ_Z const int tid = tid_, lane = tid & 63, wid = tid >> 6, G = opq_grid();
#pragma unroll 1
    for (int row0 = (blockIdx.x * 8 + wid) * NR; row0 < MH; row0 += G * 8 * NR) {
        f32x4 v[NR][4]; float ss[NR];
#pragma unroll
        for (int rr = 0; rr < NR; ++rr) { const f32x4* xr = (const f32x4*)(x + (size_t)(row0 + rr) * DM);
#pragma unroll
            for (int i = 0; i < 4; ++i) v[rr][i] = xr[lane + 64 * i]; }
#pragma unroll
        for (int rr = 0; rr < NR; ++rr) { float s = 0.f;
#pragma unroll
            for (int i = 0; i < 4; ++i) s += v[rr][i][0] * v[rr][i][0] + v[rr][i][1] * v[rr][i][1] + v[rr][i][2] * v[rr][i][2] + v[rr][i][3] * v[rr][i][3];
            ss[rr] = wave_sum(s); }
        const float* mb = modl + (size_t)(rbase + (row0 >> lshift)) * 6144;
#pragma unroll
        for (int i = 0; i < 4; ++i) { const int col = (lane + 64 * i) * 4; const f32x4 wv = *(const f32x4*)(w + col), sc = *(const f32x4*)(mb + sc_off + col), sh = *(const f32x4*)(mb + sh_off + col);
            const f32x4 wm = wv * (1.0f + sc);
#pragma unroll
            for (int rr = 0; rr < NR; ++rr) { const float rstd = rsqrtf(ss[rr] * (1.0f / 1024.0f) + EPSN);
                const f32x4 h = v[rr][i] * rstd * wm + sh; u32x2 o; o.x = pk2(h[0], h[1]); o.y = pk2(h[2], h[3]); *(u32x2*)(hb + (size_t)(row0 + rr) * DM + col) = o; } }
    }
}
__device__ __forceinline__ void final_norm(float* x, const float* w) {
    constexpr int NR = 4;
    int tid_ = threadIdx.x; asm volatile("" : "+v"(tid_)); OPQ_Z const int tid = tid_, lane = tid & 63, wid = tid >> 6, G = opq_grid();
#pragma unroll 1
    for (int row0 = (blockIdx.x * 8 + wid) * NR; row0 < MH; row0 += G * 8 * NR) {
        f32x4 v[NR][4]; float ss[NR];
#pragma unroll
        for (int rr = 0; rr < NR; ++rr) { const f32x4* xr = (const f32x4*)(x + (size_t)(row0 + rr) * DM);
#pragma unroll
            for (int i = 0; i < 4; ++i) v[rr][i] = xr[lane + 64 * i]; }
#pragma unroll
        for (int rr = 0; rr < NR; ++rr) { float s = 0.f;
#pragma unroll
            for (int i = 0; i < 4; ++i) s += v[rr][i][0] * v[rr][i][0] + v[rr][i][1] * v[rr][i][1] + v[rr][i][2] * v[rr][i][2] + v[rr][i][3] * v[rr][i][3];
            ss[rr] = wave_sum(s); }
#pragma unroll
        for (int i = 0; i < 4; ++i) { const int col = (lane + 64 * i) * 4; const f32x4 wv = *(const f32x4*)(w + col);
#pragma unroll
            for (int rr = 0; rr < NR; ++rr) { const float rstd = rsqrtf(ss[rr] * (1.0f / 1024.0f) + EPSN); ((f32x4*)(x + (size_t)(row0 + rr) * DM))[lane + 64 * i] = v[rr][i] * rstd * wv; } }
    }
}
struct RgPrm { float ba[4], bx[4], sp[4]; };
#define RG_LOAD_W(p, l, tid, Bw, prm) do { const int w_ = (tid) >> 6, hd_ = w_ >> 1, dir_ = w_ & 1, fr_ = (tid) & 15, fq_ = ((tid) & 63) >> 4; \
        _Pragma("unroll") for (int nbk_ = 0; nbk_ < 8; ++nbk_) { const float* W_ = (nbk_ < 4 ? PIN(26) : PIN(28)) + (size_t)((((l) * 2 + dir_) * 4 + hd_) * 64) * 64 + 16 * (nbk_ & 3) + fr_; \
            _Pragma("unroll") for (int ks_ = 0; ks_ < 2; ++ks_) { _Pragma("unroll") for (int e_ = 0; e_ < 8; ++e_) Bw[nbk_][ks_][e_] = (short)f2bf(W_[(32 * ks_ + 8 * fq_ + e_) * 64]); } } \
        _Pragma("unroll") for (int nb_ = 0; nb_ < 4; ++nb_) { const int j_ = 64 * hd_ + 16 * nb_ + fr_; prm.ba[nb_] = PIN(27)[((l) * 2 + dir_) * 256 + j_]; prm.bx[nb_] = PIN(29)[((l) * 2 + dir_) * 256 + j_]; \
            prm.sp[nb_] = log1pf(__expf(-PIN(30)[((l) * 2 + dir_) * 256 + j_])); } } while (0)
template <bool PASS_C>
__device__ __forceinline__ void rg_tile(const P& p, unsigned char* lds, int l, int rowb, int L, int t0, const bf16_t* __restrict__ ub, bf16_t* __restrict__ yb, const pg8::bf16x8 (&Bw)[8][2], const RgPrm& prm, int tid) {
    OPQ_Z
    float* xr = (float*)lds; bf16_t* xrb = (bf16_t*)(lds + 32768); float* hs0 = (float*)(lds + 32768 + 16896); float* hs1 = hs0 + 32 * 256;
    const int lane = tid & 63, w = __builtin_amdgcn_readfirstlane(tid >> 6), hd = w >> 1, dir = w & 1, fr = lane & 15, fq = lane >> 4;
    const int tile = (rowb + t0) >> 5;
    float* CA = (float*)(PWS + WS_RGC); float* CB = CA + 524288; float* CIN = CB + 524288;
    {
        const float* cw = PIN(24) + l * 4 * 256; const float* cbp = PIN(25) + l * 256;
#pragma unroll
        for (int r = 0; r < 2; ++r) { const int item = tid + 512 * r, cg = item & 31, t = item >> 5, tok = t0 + t, c0 = cg * 8;
            const bf16_t* up = ub + (size_t)(rowb + tok) * DIN + 3328 + c0;
            u32x4 x[4];
            x[0] = tok - 2 >= 0 ? *(const u32x4*)(up - 2 * DIN) : (u32x4){0u, 0u, 0u, 0u};
            x[1] = tok - 1 >= 0 ? *(const u32x4*)(up - DIN) : (u32x4){0u, 0u, 0u, 0u};
            x[2] = *(const u32x4*)up;
            x[3] = tok + 1 < L ? *(const u32x4*)(up + DIN) : (u32x4){0u, 0u, 0u, 0u};
            float a[8];
            { const f32x4 b0 = *(const f32x4*)(cbp + c0), b1 = *(const f32x4*)(cbp + c0 + 4); a[0] = b0[0]; a[1] = b0[1]; a[2] = b0[2]; a[3] = b0[3]; a[4] = b1[0]; a[5] = b1[1]; a[6] = b1[2]; a[7] = b1[3]; }
#pragma unroll
            for (int k2 = 0; k2 < 4; ++k2) { const f32x4 w0 = *(const f32x4*)(cw + k2 * 256 + c0), w1 = *(const f32x4*)(cw + k2 * 256 + c0 + 4);
                a[0] += w0[0] * lo16(x[k2].x); a[1] += w0[1] * hi16(x[k2].x); a[2] += w0[2] * lo16(x[k2].y); a[3] += w0[3] * hi16(x[k2].y);
                a[4] += w1[0] * lo16(x[k2].z); a[5] += w1[1] * hi16(x[k2].z); a[6] += w1[2] * lo16(x[k2].w); a[7] += w1[3] * hi16(x[k2].w); }
            *(f32x4*)(xr + t * 256 + c0) = (f32x4){a[0], a[1], a[2], a[3]}; *(f32x4*)(xr + t * 256 + c0 + 4) = (f32x4){a[4], a[5], a[6], a[7]};
            *(u32x4*)(xrb + t * 264 + c0) = (u32x4){pk2(a[0], a[1]), pk2(a[2], a[3]), pk2(a[4], a[5]), pk2(a[6], a[7])}; }
    }
    __syncthreads();
    f32x4 acc[2][8];
#pragma unroll
    for (int tb = 0; tb < 2; ++tb)
#pragma unroll
        for (int nbk = 0; nbk < 8; ++nbk) acc[tb][nbk] = (f32x4){0.f, 0.f, 0.f, 0.f};
#pragma unroll
    for (int tb = 0; tb < 2; ++tb)
#pragma unroll
        for (int ks = 0; ks < 2; ++ks) { const pg8::bf16x8 av = *(const pg8::bf16x8*)(xrb + (16 * tb + fr) * 264 + 64 * hd + 32 * ks + 8 * fq);
#pragma unroll
            for (int nbk = 0; nbk < 8; ++nbk) acc[tb][nbk] = __builtin_amdgcn_mfma_f32_16x16x32_bf16(av, Bw[nbk][ks], acc[tb][nbk], 0, 0, 0); }
    float* hsd = dir ? hs1 : hs0;
#pragma unroll
    for (int nb = 0; nb < 4; ++nb) {
        const int j = 64 * hd + 16 * nb + fr;
        float PA[2][4], PB[2][4], TA[2], TB[2];
#pragma unroll
        for (int tb = 0; tb < 2; ++tb) { float ca = 1.f, cb = 0.f;
#pragma unroll
            for (int s2 = 0; s2 < 4; ++s2) { const int jj = dir ? 3 - s2 : s2; const int t = 16 * tb + 4 * fq + jj;
                const float r = __builtin_amdgcn_rcpf(1.0f + __expf(-(acc[tb][nb][jj] + prm.ba[nb]))), ig = __builtin_amdgcn_rcpf(1.0f + __expf(-(acc[tb][nb + 4][jj] + prm.bx[nb])));
                const float la = -8.0f * r * prm.sp[nb], a = __expf(la), bt = __builtin_amdgcn_sqrtf(fmaxf(1.0f - a * a, 0.f)) * ig * xr[t * 256 + j];
                cb = a * cb + bt; ca = a * ca; PA[tb][jj] = ca; PB[tb][jj] = cb; }
            TA[tb] = ca; TB[tb] = cb; }
        float EA[2], EB[2], GA[2], GB[2];
#pragma unroll
        for (int tb = 0; tb < 2; ++tb) { float ea = 1.f, eb = 0.f, ga = 1.f, gb = 0.f;
#pragma unroll
            for (int s2 = 0; s2 < 4; ++s2) { const int qq = dir ? 3 - s2 : s2; const float ta = __shfl(TA[tb], fr + 16 * qq), tb2 = __shfl(TB[tb], fr + 16 * qq);
                const bool prec = dir ? (qq > fq) : (qq < fq);
                if (prec) { eb = ta * eb + tb2; ea = ta * ea; }
                gb = ta * gb + tb2; ga = ta * ga; }
            EA[tb] = ea; EB[tb] = eb; GA[tb] = ga; GB[tb] = gb; }
        const int f1 = dir ? 1 : 0, f2 = dir ? 0 : 1;
        EB[f2] = EA[f2] * GB[f1] + EB[f2]; EA[f2] = EA[f2] * GA[f1];
        if (!PASS_C) { if (fq == 0) { CA[(size_t)(tile * 2 + dir) * 256 + j] = GA[f1] * GA[f2]; CB[(size_t)(tile * 2 + dir) * 256 + j] = GA[f2] * GB[f1] + GB[f2]; } }
        else { const float hin = CIN[(size_t)(tile * 2 + dir) * 256 + j];
#pragma unroll
            for (int tb = 0; tb < 2; ++tb)
#pragma unroll
                for (int jj = 0; jj < 4; ++jj) { const float af = PA[tb][jj] * EA[tb], bf = PA[tb][jj] * EB[tb] + PB[tb][jj]; hsd[(16 * tb + 4 * fq + jj) * 256 + j] = af * hin + bf; } }
    }
    __syncthreads();
    if (PASS_C) {
        const int wid = tid >> 6; const float* gain = PIN(6) + l * 1024 + 768 + lane * 4;
#pragma unroll 1
        for (int r = 0; r < 4; ++r) { const int t = wid + 8 * r; const size_t row = (size_t)(rowb + t0 + t);
            const f32x4 a = *(const f32x4*)(hs0 + t * 256 + lane * 4), b = *(const f32x4*)(hs1 + t * 256 + lane * 4);
            const u32x2 gw = *(const u32x2*)(ub + row * DIN + 3584 + lane * 4);
            const float gt[4] = {lo16(gw.x), hi16(gw.x), lo16(gw.y), hi16(gw.y)};
            float y[4], ss = 0.f;
#pragma unroll
            for (int e = 0; e < 4; ++e) { const float x = gt[e]; const float ge = x * (1.0f - __builtin_amdgcn_rcpf(1.0f + __expf(1.5957691216f * (x + 0.044715f * x * x * x)))); y[e] = (a[e] + b[e]) * ge; ss += y[e] * y[e]; }
            ss = wave_sum(ss);
            const float rstd = rsqrtf(ss * (1.0f / 256.0f) + EPSN);
            u32x2 o; o.x = pk2(y[0] * rstd * gain[0], y[1] * rstd * gain[1]); o.y = pk2(y[2] * rstd * gain[2], y[3] * rstd * gain[3]);
            *(u32x2*)(yb + row * DM + 768 + lane * 4) = o; }
        __syncthreads();
    }
}
__device__ __forceinline__ void rg_carry(const P& p, int B, int L) {
    int tid_ = threadIdx.x; asm volatile("" : "+v"(tid_)); OPQ_Z const int tid = tid_, lane = tid & 63, w = tid >> 6, G = opq_grid();
    const int ntl = L >> 5, per = ntl >> 6;
    const float* __restrict__ CA = (const float*)(PWS + WS_RGC); const float* __restrict__ CB = CA + 524288; float* __restrict__ CIN = (float*)(PWS + WS_RGC) + 2 * 524288;
#pragma unroll 1
    for (int ch = blockIdx.x * 8 + w; ch < B * 512; ch += G * 8) {
        const int b = ch >> 9, dir = (ch >> 8) & 1, j = ch & 255, tb = b * ntl;
        float a[8], bb[8], PA[8], PB[8]; float ca = 1.f, cb = 0.f;
#pragma unroll
        for (int i = 0; i < 8; ++i) if (i < per) { const int pidx = lane * per + i, k = dir ? ntl - 1 - pidx : pidx; const size_t idx = (size_t)((tb + k) * 2 + dir) * 256 + j; a[i] = CA[idx]; bb[i] = CB[idx]; }
#pragma unroll
        for (int i = 0; i < 8; ++i) if (i < per) { cb = a[i] * cb + bb[i]; ca = a[i] * ca; PA[i] = ca; PB[i] = cb; }
#pragma unroll
        for (int off = 1; off < 64; off <<= 1) { const float ta = __shfl_up(ca, off), tb2 = __shfl_up(cb, off); if (lane >= off) { cb = ca * tb2 + cb; ca = ca * ta; } }
        float eb = __shfl_up(cb, 1); if (lane == 0) eb = 0.f;
#pragma unroll
        for (int i = 0; i < 8; ++i) if (i < per) { const int pidx = lane * per + i, k = dir ? ntl - 1 - pidx : pidx; const size_t idx = (size_t)((tb + k) * 2 + dir) * 256 + j;
            CIN[idx] = (i == 0) ? eb : (PA[i - 1 < 0 ? 0 : i - 1] * eb + PB[i - 1 < 0 ? 0 : i - 1]); }
    }
}

constexpr size_t WS_HGU = 514334720, WS_HGD = 531111936, WS_BAR = 531243008, WS_NEED = 531243008 + 16384;
#define HG_BAR() do { asm volatile("s_waitcnt lgkmcnt(0)" ::: "memory"); __builtin_amdgcn_s_barrier(); asm volatile("" ::: "memory"); } while (0)
#ifdef HG32
#define HGSEG hg_seg
#else
#define HGSEG hg_seg64
#endif
template <bool FULL>
__device__ __forceinline__ void hg_seg(const P& p, unsigned char* lds, int l, int item, int L, int tid) {
    OPQ_Z
    const int lane = tid & 63, w = __builtin_amdgcn_readfirstlane(tid >> 6), fr = lane & 15, fq = lane >> 4, k = tid & 127, g = tid >> 7;
    const int nseg = L >> 10, chain = item / nseg, pseg = item - chain * nseg, b = chain >> 3, h = (chain >> 1) & 3, dir = chain & 1;
    const bf16_t* __restrict__ ub = (const bf16_t*)(PWS + WS_U); bf16_t* __restrict__ ob = (bf16_t*)(PWS + (dir ? WS_OB : WS_OF));
    float* __restrict__ Ug = (float*)(PWS + WS_HGU); float* __restrict__ Dg = (float*)(PWS + WS_HGD);
    bf16_t* QH = (bf16_t*)lds; bf16_t* QT = QH + 32 * 136; bf16_t* KT = QT + 32 * 136; bf16_t* KHT = KT + 48 * 136; bf16_t* VT = KHT + 128 * 40; bf16_t* ST = VT + 128 * 40; bf16_t* AM = ST + 128 * 136;
    float* GT = (float*)(AM + 32 * 40); float* DL = GT + 512;
    const float lbv = ((const float*)(PWS + WS_LB))[(dir * 2 + l) * 512 + h * 128 + k];
    const int zoff = (dir ? 2304 : 1792) + h * 128 + k, qoff = 768 + h * 128 + k, voff = 1280 + h * 128 + k;
    f32x4 S[8];
#pragma unroll
    for (int kb = 0; kb < 8; ++kb) S[kb] = (f32x4){0.f, 0.f, 0.f, 0.f};
    if (FULL) {
#pragma unroll 1
        for (int sp = 0; sp < pseg; ++sp) { const float* Up = Ug + (size_t)(chain * nseg + sp) * 16384 + 16 * w + fr; const float* Dp = Dg + (size_t)(chain * nseg + sp) * 128;
#pragma unroll
            for (int kb = 0; kb < 8; ++kb)
#pragma unroll
                for (int j = 0; j < 4; ++j) { const int kk = 16 * kb + 4 * fq + j; S[kb][j] = Dp[kk] * S[kb][j] + Up[(size_t)kk * 128]; } }
        for (int e = tid; e < 16 * 16; e += 512) AM[(e >> 4) * 40 + 16 + (e & 15)] = 0;
    }
    float dsum = 0.f;
    bf16_t rz[8], rv[8], rq[8];
    { const int n0 = pseg * 1024 + 8 * g;
#pragma unroll
      for (int i = 0; i < 8; ++i) { const int n = n0 + i, t = dir ? L - 1 - n : n; const bf16_t* up = ub + (size_t)(b * L + t) * DIN;
          rz[i] = up[zoff]; rv[i] = up[voff]; rq[i] = FULL ? up[qoff] : (bf16_t)0; } }
#pragma unroll 1
    for (int c = 0; c < 32; ++c) {
        float zz[8], qq[8], vv[8];
#pragma unroll
        for (int i = 0; i < 8; ++i) { zz[i] = bf2f(rz[i]); vv[i] = bf2f(rv[i]); if (FULL) qq[i] = bf2f(rq[i]); }
        if (c + 1 < 32) { const int n0 = pseg * 1024 + 32 * (c + 1) + 8 * g;
#pragma unroll
            for (int i = 0; i < 8; ++i) { const int n = n0 + i, t = dir ? L - 1 - n : n; const bf16_t* up = ub + (size_t)(b * L + t) * DIN;
                rz[i] = up[zoff]; rv[i] = up[voff]; if (FULL) rq[i] = up[qoff]; } }
        float bb[8], kk[8]; float run = 0.f;
#pragma unroll
        for (int i = 0; i < 8; ++i) { const float E = __builtin_amdgcn_exp2f(-1.44269504f * fmaxf(zz[i], -80.f)), rd = __builtin_amdgcn_rcpf(1.0f + E);
            run += __builtin_amdgcn_logf((1.0f + lbv * E) * rd); bb[i] = run; kk[i] = (1.0f - lbv) * E * rd; }
        GT[g * 128 + k] = run;
        if (FULL) {
#pragma unroll
            for (int kb = 0; kb < 8; ++kb) { u32x2 o; o.x = pk2_sw(S[kb][0], S[kb][1]); o.y = pk2_sw(S[kb][2], S[kb][3]); *(u32x2*)(ST + (16 * w + fr) * 136 + 16 * kb + 4 * fq) = o; }
        }
        HG_BAR();
        const float g0 = GT[k], g1 = GT[128 + k], g2 = GT[256 + k], g3 = GT[384 + k];
        const float r1 = g0 + g1, blast = r1 + g2 + g3;
        const float pre = g == 0 ? 0.f : (g == 1 ? g0 : (g == 2 ? r1 : r1 + g2));
        {
            unsigned kh[4], vt[4]; float khf[8];
#pragma unroll
            for (int i = 0; i < 8; ++i) { const float bv = pre + bb[i]; const int tau = 8 * g + i;
                khf[i] = kk[i] * __builtin_amdgcn_exp2f(blast - bv);
                if (FULL) {
                    const float qh = qq[i] * __builtin_amdgcn_exp2f(bv);
                    const float qt = g < 2 ? qh : qq[i] * __builtin_amdgcn_exp2f(bv - r1);
                    QH[tau * 136 + k] = (bf16_t)pg8::cvt_pk_bf16(qh, 0.f);
                    QT[tau * 136 + k] = (bf16_t)pg8::cvt_pk_bf16(qt, 0.f);
                    KT[(16 + tau) * 136 + k] = (bf16_t)pg8::cvt_pk_bf16(kk[i] * __builtin_amdgcn_exp2f(fminf(r1 - bv, 86.f)), 0.f);
                    if (g < 2) KT[tau * 136 + k] = (bf16_t)pg8::cvt_pk_bf16(kk[i] * __builtin_amdgcn_exp2f(fminf(-bv, 86.f)), 0.f);
                } }
#pragma unroll
            for (int i2 = 0; i2 < 4; ++i2) { kh[i2] = pg8::cvt_pk_bf16(khf[2 * i2], khf[2 * i2 + 1]); vt[i2] = pg8::cvt_pk_bf16(vv[2 * i2], vv[2 * i2 + 1]); }
            *(u32x4*)(KHT + k * 40 + 8 * g) = (u32x4){kh[0], kh[1], kh[2], kh[3]};
            *(u32x4*)(VT + k * 40 + 8 * g) = (u32x4){vt[0], vt[1], vt[2], vt[3]};
            if (g == 0) { DL[k] = __builtin_amdgcn_exp2f(blast); dsum += blast; }
        }
        HG_BAR();
        f32x4 o[2];
        if (FULL) {
            if (w < 3) {
                const int I = w == 0 ? 0 : 1, J = w == 2 ? 1 : 0;
                f32x4 a = (f32x4){0.f, 0.f, 0.f, 0.f};
#pragma unroll
                for (int ks = 0; ks < 4; ++ks) { const pg8::bf16x8 qa = *(const pg8::bf16x8*)(QT + (16 * I + fr) * 136 + 32 * ks + 8 * fq), kb2 = *(const pg8::bf16x8*)(KT + ((I ? 16 : 0) + 16 * J + fr) * 136 + 32 * ks + 8 * fq);
                    a = __builtin_amdgcn_mfma_f32_16x16x32_bf16(qa, kb2, a, 0, 0, 0); }
#pragma unroll
                for (int j = 0; j < 4; ++j) { const float val = (I != J || fr <= 4 * fq + j) ? a[j] : 0.f; AM[(16 * I + 4 * fq + j) * 40 + 16 * J + fr] = f2bf(val); }
            }
#pragma unroll
            for (int tb = 0; tb < 2; ++tb) { o[tb] = (f32x4){0.f, 0.f, 0.f, 0.f};
#pragma unroll
                for (int ks = 0; ks < 4; ++ks) { const pg8::bf16x8 qa = *(const pg8::bf16x8*)(QH + (16 * tb + fr) * 136 + 32 * ks + 8 * fq), sb = *(const pg8::bf16x8*)(ST + (16 * w + fr) * 136 + 32 * ks + 8 * fq);
                    o[tb] = __builtin_amdgcn_mfma_f32_16x16x32_bf16(qa, sb, o[tb], 0, 0, 0); } }
            HG_BAR();
        }
        const pg8::bf16x8 vb = *(const pg8::bf16x8*)(VT + (16 * w + fr) * 40 + 8 * fq);
        if (FULL) {
#pragma unroll
            for (int tb = 0; tb < 2; ++tb) { const pg8::bf16x8 aa = *(const pg8::bf16x8*)(AM + (16 * tb + fr) * 40 + 8 * fq);
                o[tb] = __builtin_amdgcn_mfma_f32_16x16x32_bf16(aa, vb, o[tb], 0, 0, 0);
#pragma unroll
                for (int j = 0; j < 4; ++j) { const int n = pseg * 1024 + 32 * c + 16 * tb + 4 * fq + j, t = dir ? L - 1 - n : n; ob[(size_t)(b * L + t) * 512 + h * 128 + 16 * w + fr] = f2bf(o[tb][j]); } }
        }
#pragma unroll
        for (int kb = 0; kb < 8; ++kb) { const pg8::bf16x8 ka = *(const pg8::bf16x8*)(KHT + (16 * kb + fr) * 40 + 8 * fq); const f32x4 dl = *(const f32x4*)(DL + 16 * kb + 4 * fq);
            S[kb] = __builtin_amdgcn_mfma_f32_16x16x32_bf16(ka, vb, S[kb] * dl, 0, 0, 0); }
    }
    if (!FULL) {
        float* Up = Ug + (size_t)item * 16384 + 16 * w + fr;
#pragma unroll
        for (int kb = 0; kb < 8; ++kb)
#pragma unroll
            for (int j = 0; j < 4; ++j) Up[(size_t)(16 * kb + 4 * fq + j) * 128] = S[kb][j];
        if (g == 0) Dg[(size_t)item * 128 + k] = __builtin_amdgcn_exp2f(dsum);
    }
    __syncthreads();
}


template <bool FULL>
__device__ __forceinline__ void hg_seg64(const P& p, unsigned char* lds, int l, int item, int L, int tid) {
    OPQ_Z
    const int lane = tid & 63, w = __builtin_amdgcn_readfirstlane(tid >> 6), fr = lane & 15, fq = lane >> 4, k = tid & 127, g = tid >> 7;
    const int nseg = L >> 10, chain = item / nseg, pseg = item - chain * nseg, b = chain >> 3, h = (chain >> 1) & 3, dir = chain & 1;
    const bf16_t* __restrict__ ub = (const bf16_t*)(PWS + WS_U); bf16_t* __restrict__ ob = (bf16_t*)(PWS + (dir ? WS_OB : WS_OF));
    float* __restrict__ Ug = (float*)(PWS + WS_HGU); float* __restrict__ Dg = (float*)(PWS + WS_HGD);
    bf16_t* QH = (bf16_t*)lds; bf16_t* QT = QH + 64 * 136; bf16_t* KT = QT + 32 * 136; bf16_t* KHT = KT + 96 * 136; bf16_t* VT = KHT + 128 * 72; bf16_t* ST = VT + 128 * 72; bf16_t* AM = ST + 128 * 136;
    float* GT = (float*)(AM + 64 * 72); float* DL = GT + 512;
    const float lbv = ((const float*)(PWS + WS_LB))[(dir * 2 + l) * 512 + h * 128 + k];
    const int zoff = (dir ? 2304 : 1792) + h * 128 + k, qoff = 768 + h * 128 + k, voff = 1280 + h * 128 + k;
    f32x4 S[8];
#pragma unroll
    for (int kb = 0; kb < 8; ++kb) S[kb] = (f32x4){0.f, 0.f, 0.f, 0.f};
    if (FULL) {
        if (pseg > 0) {
            f32x4 Pd[8];
            { const float* Up = Ug + (size_t)(chain * nseg + pseg - 1) * 16384 + 16 * w + fr; const float* Dp = Dg + (size_t)(chain * nseg + pseg - 1) * 128;
#pragma unroll
              for (int kb = 0; kb < 8; ++kb)
#pragma unroll
                  for (int j = 0; j < 4; ++j) { const int kk = 16 * kb + 4 * fq + j; S[kb][j] = Up[(size_t)kk * 128]; Pd[kb][j] = Dp[kk]; } }
#pragma unroll 1
            for (int sp = pseg - 2; sp >= 0; --sp) {
                bool nz = false;
#pragma unroll
                for (int kb = 0; kb < 8; ++kb) nz = nz || (Pd[kb][0] != 0.f) || (Pd[kb][1] != 0.f) || (Pd[kb][2] != 0.f) || (Pd[kb][3] != 0.f);
                if (!__any(nz)) break;
                const float* Up = Ug + (size_t)(chain * nseg + sp) * 16384 + 16 * w + fr; const float* Dp = Dg + (size_t)(chain * nseg + sp) * 128;
#pragma unroll
                for (int kb = 0; kb < 8; ++kb)
#pragma unroll
                    for (int j = 0; j < 4; ++j) { const int kk = 16 * kb + 4 * fq + j; S[kb][j] += Pd[kb][j] * Up[(size_t)kk * 128]; Pd[kb][j] *= Dp[kk]; } }
        }
        for (int e = tid; e < 64 * 72 / 8; e += 512) *(u32x4*)(AM + e * 8) = (u32x4){0u, 0u, 0u, 0u};
    }
    float dsum = 0.f;
    bf16_t rz[16], rv[16], rq[16];
    { const int n0 = pseg * 1024 + 16 * g;
#pragma unroll
      for (int i = 0; i < 16; ++i) { const int n = n0 + i, t = dir ? L - 1 - n : n; const bf16_t* up = ub + (size_t)(b * L + t) * DIN;
          rz[i] = up[zoff]; rv[i] = up[voff]; rq[i] = FULL ? up[qoff] : (bf16_t)0; } }
#pragma unroll 1
    for (int c = 0; c < 16; ++c) {
        float qq[16], vv[16], bb[16], kk[16]; float run = 0.f;
#pragma unroll
        for (int i = 0; i < 16; ++i) { const float zz = bf2f(rz[i]); vv[i] = bf2f(rv[i]); qq[i] = FULL ? bf2f(rq[i]) : 0.f;
            const float E = __builtin_amdgcn_exp2f(-1.44269504f * fmaxf(zz, -80.f)), rd = __builtin_amdgcn_rcpf(1.0f + E);
            run += __builtin_amdgcn_logf((1.0f + lbv * E) * rd); bb[i] = run; kk[i] = (1.0f - lbv) * E * rd; }
        GT[g * 128 + k] = run;
        if (FULL) {
#pragma unroll
            for (int kb = 0; kb < 8; ++kb) { u32x2 o; o.x = pk2_sw(S[kb][0], S[kb][1]); o.y = pk2_sw(S[kb][2], S[kb][3]); *(u32x2*)(ST + (16 * w + fr) * 136 + 16 * kb + 4 * fq) = o; }
        }
        HG_BAR();
        const float g0 = GT[k], g1 = GT[128 + k], g2 = GT[256 + k], g3 = GT[384 + k];
        const float r1 = g0 + g1, blast = r1 + g2 + g3;
        const float pre = g == 0 ? 0.f : (g == 1 ? g0 : (g == 2 ? r1 : r1 + g2));
        {
            float khf[16];
#pragma unroll
            for (int i = 0; i < 16; ++i) { const float bv = pre + bb[i]; const int tau = 16 * g + i;
                khf[i] = kk[i] * __builtin_amdgcn_exp2f(blast - bv);
                if (FULL) {
                    QH[tau * 136 + k] = (bf16_t)pg8::cvt_pk_bf16(qq[i] * __builtin_amdgcn_exp2f(bv), 0.f);
                    if (g >= 2) QT[(tau - 32) * 136 + k] = (bf16_t)pg8::cvt_pk_bf16(qq[i] * __builtin_amdgcn_exp2f(bv - r1), 0.f);
                    KT[(32 + tau) * 136 + k] = (bf16_t)pg8::cvt_pk_bf16(kk[i] * __builtin_amdgcn_exp2f(fminf(r1 - bv, 86.f)), 0.f);
                    if (g < 2) KT[tau * 136 + k] = (bf16_t)pg8::cvt_pk_bf16(kk[i] * __builtin_amdgcn_exp2f(fminf(-bv, 86.f)), 0.f);
                } }
            unsigned kh[8], vt[8];
#pragma unroll
            for (int i2 = 0; i2 < 8; ++i2) { kh[i2] = pg8::cvt_pk_bf16(khf[2 * i2], khf[2 * i2 + 1]); vt[i2] = pg8::cvt_pk_bf16(vv[2 * i2], vv[2 * i2 + 1]); }
            *(u32x4*)(KHT + k * 72 + 16 * g) = (u32x4){kh[0], kh[1], kh[2], kh[3]}; *(u32x4*)(KHT + k * 72 + 16 * g + 8) = (u32x4){kh[4], kh[5], kh[6], kh[7]};
            *(u32x4*)(VT + k * 72 + 16 * g) = (u32x4){vt[0], vt[1], vt[2], vt[3]}; *(u32x4*)(VT + k * 72 + 16 * g + 8) = (u32x4){vt[4], vt[5], vt[6], vt[7]};
            if (g == 0) { DL[k] = __builtin_amdgcn_exp2f(blast); dsum += blast; }
        }
        HG_BAR();
        if (c + 1 < 16) { const int n0 = pseg * 1024 + 64 * (c + 1) + 16 * g;
#pragma unroll
            for (int i = 0; i < 16; ++i) { const int n = n0 + i, t = dir ? L - 1 - n : n; const bf16_t* up = ub + (size_t)(b * L + t) * DIN;
                rz[i] = up[zoff]; rv[i] = up[voff]; if (FULL) rq[i] = up[qoff]; } }
        f32x4 o[4];
        if (FULL) {
#pragma unroll 1
            for (int idx = w; idx < 10; idx += 8) {
                const int a = idx < 1 ? 0 : (idx < 3 ? 1 : (idx < 6 ? 2 : 3)), cc = idx - a * (a + 1) / 2;
                const bf16_t* qrow = (a < 2) ? (QH + (16 * a + fr) * 136) : (QT + (16 * a - 32 + fr) * 136);
                const bf16_t* krow = KT + ((a < 2 ? 0 : 32) + 16 * cc + fr) * 136;
                f32x4 av = (f32x4){0.f, 0.f, 0.f, 0.f};
#pragma unroll
                for (int ks = 0; ks < 4; ++ks) av = __builtin_amdgcn_mfma_f32_16x16x32_bf16(*(const pg8::bf16x8*)(qrow + 32 * ks + 8 * fq), *(const pg8::bf16x8*)(krow + 32 * ks + 8 * fq), av, 0, 0, 0);
#pragma unroll
                for (int j = 0; j < 4; ++j) { const float val = (a != cc || fr <= 4 * fq + j) ? av[j] : 0.f; AM[(16 * a + 4 * fq + j) * 72 + 16 * cc + fr] = f2bf(val); }
            }
            __builtin_amdgcn_s_setprio(1);
#pragma unroll
            for (int tb = 0; tb < 4; ++tb) { o[tb] = (f32x4){0.f, 0.f, 0.f, 0.f};
#pragma unroll
                for (int ks = 0; ks < 4; ++ks) o[tb] = __builtin_amdgcn_mfma_f32_16x16x32_bf16(*(const pg8::bf16x8*)(QH + (16 * tb + fr) * 136 + 32 * ks + 8 * fq), *(const pg8::bf16x8*)(ST + (16 * w + fr) * 136 + 32 * ks + 8 * fq), o[tb], 0, 0, 0); }
            __builtin_amdgcn_s_setprio(0);
            HG_BAR();
        }
        const pg8::bf16x8 vb0 = *(const pg8::bf16x8*)(VT + (16 * w + fr) * 72 + 8 * fq), vb1 = *(const pg8::bf16x8*)(VT + (16 * w + fr) * 72 + 32 + 8 * fq);
        if (FULL) {
#pragma unroll
            for (int tb = 0; tb < 4; ++tb) {
                o[tb] = __builtin_amdgcn_mfma_f32_16x16x32_bf16(*(const pg8::bf16x8*)(AM + (16 * tb + fr) * 72 + 8 * fq), vb0, o[tb], 0, 0, 0);
                if (tb >= 2) o[tb] = __builtin_amdgcn_mfma_f32_16x16x32_bf16(*(const pg8::bf16x8*)(AM + (16 * tb + fr) * 72 + 32 + 8 * fq), vb1, o[tb], 0, 0, 0);
#pragma unroll
                for (int j = 0; j < 4; ++j) { const int n = pseg * 1024 + 64 * c + 16 * tb + 4 * fq + j, t = dir ? L - 1 - n : n; ob[(size_t)(b * L + t) * 512 + h * 128 + 16 * w + fr] = f2bf(o[tb][j]); } }
        }
        __builtin_amdgcn_s_setprio(1);
#pragma unroll
        for (int kb = 0; kb < 8; ++kb) { const f32x4 dl = *(const f32x4*)(DL + 16 * kb + 4 * fq);
            S[kb] = __builtin_amdgcn_mfma_f32_16x16x32_bf16(*(const pg8::bf16x8*)(KHT + (16 * kb + fr) * 72 + 8 * fq), vb0, S[kb] * dl, 0, 0, 0);
            S[kb] = __builtin_amdgcn_mfma_f32_16x16x32_bf16(*(const pg8::bf16x8*)(KHT + (16 * kb + fr) * 72 + 32 + 8 * fq), vb1, S[kb], 0, 0, 0); }
        __builtin_amdgcn_s_setprio(0);
    }
    if (!FULL) {
        float* Up = Ug + (size_t)item * 16384 + 16 * w + fr;
#pragma unroll
        for (int kb = 0; kb < 8; ++kb)
#pragma unroll
            for (int j = 0; j < 4; ++j) Up[(size_t)(16 * kb + 4 * fq + j) * 128] = S[kb][j];
        if (g == 0) Dg[(size_t)item * 128 + k] = __builtin_amdgcn_exp2f(dsum);
    }
    __syncthreads();
}


__device__ __forceinline__ void hg_passA64(const P& p, unsigned char* lds, int l, int item, int L, int tid) {
    OPQ_Z
    const int lane = tid & 63, w = __builtin_amdgcn_readfirstlane(tid >> 6), fr = lane & 15, fq = lane >> 4, k = tid & 127, g = tid >> 7;
    const int nseg = L >> 10, chain = item / nseg, pseg = item - chain * nseg, b = chain >> 3, h = (chain >> 1) & 3, dir = chain & 1;
    const bf16_t* __restrict__ ub = (const bf16_t*)(PWS + WS_U);
    float* __restrict__ Ug = (float*)(PWS + WS_HGU); float* __restrict__ Dg = (float*)(PWS + WS_HGD);
    bf16_t* KHT = (bf16_t*)lds; bf16_t* VT = KHT + 128 * 72; float* GT = (float*)(VT + 128 * 72); unsigned* NZ = (unsigned*)(GT + 512);
    const float lbv = ((const float*)(PWS + WS_LB))[(dir * 2 + l) * 512 + h * 128 + k];
    const int zoff = (dir ? 2304 : 1792) + h * 128 + k, voff = 1280 + h * 128 + k;
    f32x4 S[8];
#pragma unroll
    for (int kb = 0; kb < 8; ++kb) S[kb] = (f32x4){0.f, 0.f, 0.f, 0.f};
    float Pk = 1.0f;
    bf16_t rz[16], rv[16];
    { const int n0 = pseg * 1024 + 64 * 15 + 16 * g;
#pragma unroll
      for (int i = 0; i < 16; ++i) { const int n = n0 + i, t = dir ? L - 1 - n : n; const bf16_t* up = ub + (size_t)(b * L + t) * DIN; rz[i] = up[zoff]; rv[i] = up[voff]; } }
#pragma unroll 1
    for (int c = 15; c >= 0; --c) {
        float vv[16], bb[16], kk[16]; float run = 0.f;
#pragma unroll
        for (int i = 0; i < 16; ++i) { const float zz = bf2f(rz[i]); vv[i] = bf2f(rv[i]);
            const float E = __builtin_amdgcn_exp2f(-1.44269504f * fmaxf(zz, -80.f)), rd = __builtin_amdgcn_rcpf(1.0f + E);
            run += __builtin_amdgcn_logf((1.0f + lbv * E) * rd); bb[i] = run; kk[i] = (1.0f - lbv) * E * rd; }
        if (c > 0) { const int n0 = pseg * 1024 + 64 * (c - 1) + 16 * g;
#pragma unroll
            for (int i = 0; i < 16; ++i) { const int n = n0 + i, t = dir ? L - 1 - n : n; const bf16_t* up = ub + (size_t)(b * L + t) * DIN; rz[i] = up[zoff]; rv[i] = up[voff]; } }
        GT[g * 128 + k] = run;
        HG_BAR();
        const float g0 = GT[k], g1 = GT[128 + k], g2 = GT[256 + k], g3 = GT[384 + k];
        const float r1 = g0 + g1, blast = r1 + g2 + g3;
        const float pre = g == 0 ? 0.f : (g == 1 ? g0 : (g == 2 ? r1 : r1 + g2));
        {
            unsigned kh[8], vt[8];
#pragma unroll
            for (int i2 = 0; i2 < 8; ++i2) { const float k0 = kk[2 * i2] * __builtin_amdgcn_exp2f(blast - (pre + bb[2 * i2])) * Pk, k1 = kk[2 * i2 + 1] * __builtin_amdgcn_exp2f(blast - (pre + bb[2 * i2 + 1])) * Pk;
                kh[i2] = pg8::cvt_pk_bf16(k0, k1); vt[i2] = pg8::cvt_pk_bf16(vv[2 * i2], vv[2 * i2 + 1]); }
            *(u32x4*)(KHT + k * 72 + 16 * g) = (u32x4){kh[0], kh[1], kh[2], kh[3]}; *(u32x4*)(KHT + k * 72 + 16 * g + 8) = (u32x4){kh[4], kh[5], kh[6], kh[7]};
            *(u32x4*)(VT + k * 72 + 16 * g) = (u32x4){vt[0], vt[1], vt[2], vt[3]}; *(u32x4*)(VT + k * 72 + 16 * g + 8) = (u32x4){vt[4], vt[5], vt[6], vt[7]};
        }
        Pk *= __builtin_amdgcn_exp2f(blast);
        { const bool anynz = __any(Pk != 0.f); if (lane == 0) NZ[w] = anynz ? 1u : 0u; }
        HG_BAR();
        const pg8::bf16x8 vb0 = *(const pg8::bf16x8*)(VT + (16 * w + fr) * 72 + 8 * fq), vb1 = *(const pg8::bf16x8*)(VT + (16 * w + fr) * 72 + 32 + 8 * fq);
        const unsigned nzall = NZ[0] | NZ[1] | NZ[2] | NZ[3] | NZ[4] | NZ[5] | NZ[6] | NZ[7];
        __builtin_amdgcn_s_setprio(1);
#pragma unroll
        for (int kb = 0; kb < 8; ++kb) {
            S[kb] = __builtin_amdgcn_mfma_f32_16x16x32_bf16(*(const pg8::bf16x8*)(KHT + (16 * kb + fr) * 72 + 8 * fq), vb0, S[kb], 0, 0, 0);
            S[kb] = __builtin_amdgcn_mfma_f32_16x16x32_bf16(*(const pg8::bf16x8*)(KHT + (16 * kb + fr) * 72 + 32 + 8 * fq), vb1, S[kb], 0, 0, 0); }
        __builtin_amdgcn_s_setprio(0);
        if (nzall == 0u) break;
    }
    {
        float* Up = Ug + (size_t)item * 16384 + 16 * w + fr;
#pragma unroll
        for (int kb = 0; kb < 8; ++kb)
#pragma unroll
            for (int j = 0; j < 4; ++j) Up[(size_t)(16 * kb + 4 * fq + j) * 128] = S[kb][j];
        if (g == 0) Dg[(size_t)item * 128 + k] = Pk;
    }
    __syncthreads();
}

__device__ __forceinline__ void prep_phase(const P& p, unsigned char* lds, int l, int B, int L) {
    int tid_ = threadIdx.x; asm volatile("" : "+v"(tid_)); OPQ_Z const int tid = tid_, G = opq_grid();
    pg8::bf16x8 Bw[8][2]; RgPrm prm; RG_LOAD_W(p, l, tid, Bw, prm);
    const bf16_t* __restrict__ ub = (const bf16_t*)(PWS + WS_U); bf16_t* __restrict__ vT = (bf16_t*)(PWS + WS_VT);
    bf16_t* sm = (bf16_t*)lds;
    const float* cw = PIN(12) + l * 3 * 768; const float* cb = PIN(13) + l * 768;
#pragma unroll 1
    for (int tile = blockIdx.x; tile < MH / 64; tile += G) {
        const int r0 = tile * 64, rowb = (r0 / L) * L, t0 = r0 - rowb;
#pragma unroll 4
        for (int r = 0; r < 4; ++r) { const int item = tid + 512 * r, cg = item & 31, t = item >> 5, tok = t0 + t, c0 = cg * 8;
            const bf16_t* up = ub + (size_t)(r0 + t) * DIN + c0;
            float x1[8], vv[8];
            { const f32x4 b0 = *(const f32x4*)(cb + 256 + c0), b1 = *(const f32x4*)(cb + 256 + c0 + 4), d0 = *(const f32x4*)(cb + 512 + c0), d1 = *(const f32x4*)(cb + 512 + c0 + 4);
#pragma unroll
              for (int e = 0; e < 4; ++e) { x1[e] = b0[e]; x1[4 + e] = b1[e]; vv[e] = d0[e]; vv[4 + e] = d1[e]; } }
#pragma unroll
            for (int k2 = 0; k2 < 3; ++k2) { const int tt = tok + k2 - 1;
                if (tt >= 0 && tt < L) { const u32x4 xa = *(const u32x4*)(up + (k2 - 1) * DIN + 256), xb = *(const u32x4*)(up + (k2 - 1) * DIN + 512);
                    const float* wa = cw + k2 * 768 + 256 + c0; const float* wb = cw + k2 * 768 + 512 + c0;
                    const f32x4 a0 = *(const f32x4*)wa, a1 = *(const f32x4*)(wa + 4), e0 = *(const f32x4*)wb, e1 = *(const f32x4*)(wb + 4);
                    x1[0] += a0[0] * lo16(xa.x); x1[1] += a0[1] * hi16(xa.x); x1[2] += a0[2] * lo16(xa.y); x1[3] += a0[3] * hi16(xa.y);
                    x1[4] += a1[0] * lo16(xa.z); x1[5] += a1[1] * hi16(xa.z); x1[6] += a1[2] * lo16(xa.w); x1[7] += a1[3] * hi16(xa.w);
                    vv[0] += e0[0] * lo16(xb.x); vv[1] += e0[1] * hi16(xb.x); vv[2] += e0[2] * lo16(xb.y); vv[3] += e0[3] * hi16(xb.y);
                    vv[4] += e1[0] * lo16(xb.z); vv[5] += e1[1] * hi16(xb.z); vv[6] += e1[2] * lo16(xb.w); vv[7] += e1[3] * hi16(xb.w); } }
#pragma unroll
            for (int e = 0; e < 8; ++e) sm[(c0 + e) * 72 + t] = f2bf(vv[e] * x1[e]); }
        __syncthreads();
        for (int e = tid; e < 256 * 8; e += 512) { const int c = e >> 3, t8 = e & 7; *(u32x4*)(vT + (size_t)c * MH + r0 + 8 * t8) = *(const u32x4*)(sm + c * 72 + 8 * t8); }
        __syncthreads();
#pragma unroll 1
        for (int sub = 0; sub < 2; ++sub) rg_tile<false>(p, lds, l, rowb, L, t0 + 32 * sub, ub, nullptr, Bw, prm, tid);
    }
#ifndef HG_NAIVE
    { int t2_ = threadIdx.x; asm volatile("" : "+v"(t2_));
#pragma unroll 1
      for (int it = blockIdx.x; it < 256; it += G) hg_passA64(p, lds, l, it, L, t2_);
#ifdef DUP_HG
      for (int it = blockIdx.x; it < 256; it += G) HGSEG<false>(p, lds, l, it, L, t2_);
#endif
    }
#endif
}

__device__ __forceinline__ void hy_conv_naive(const P& p, unsigned char* lds, int B, int L) {
    int tid_ = threadIdx.x; asm volatile("" : "+v"(tid_)); OPQ_Z const int tid = tid_, G = opq_grid();
    const bf16_t* __restrict__ vT = (const bf16_t*)(PWS + WS_VT); const bf16_t* __restrict__ Gf = (const bf16_t*)(PWS + WS_G); float* __restrict__ yT = (float*)(PWS + WS_YT);
    bf16_t* vs = (bf16_t*)lds; bf16_t* gs = vs + 16384;
#pragma unroll 1
    for (int it = blockIdx.x; it < 256 * B; it += G) { const int c = it / B, b = it % B;
        for (int e = tid; e < L; e += 512) vs[e] = vT[(size_t)c * MH + b * L + e];
        for (int e = tid; e < 2 * L + 64; e += 512) gs[e] = Gf[(size_t)c * GLEN + e];
        __syncthreads();
#pragma unroll 1
        for (int t = tid; t < L; t += 512) { float acc = 0.f; const bf16_t* gp = gs + 32 + L - t;
            for (int s = 0; s < L; ++s) acc += bf2f(gp[s]) * bf2f(vs[s]);
            yT[(size_t)c * MH + b * L + t] = acc; }
        __syncthreads();
    }
}


__device__ __forceinline__ void hy_conv_mfma(const P& p, unsigned char* lds, int B, int L) {
    int tid_ = threadIdx.x; asm volatile("" : "+v"(tid_)); OPQ_Z const int tid = tid_, G = opq_grid(), lane = tid & 63, wid = __builtin_amdgcn_readfirstlane(tid >> 6), fr = lane & 15, fq = lane >> 4;
    const bf16_t* __restrict__ vT = (const bf16_t*)(PWS + WS_VT); const bf16_t* __restrict__ Gf = (const bf16_t*)(PWS + WS_G); float* __restrict__ yT = (float*)(PWS + WS_YT);
    bf16_t* vbuf = (bf16_t*)lds; bf16_t* zbuf = vbuf + MH; bf16_t* gbuf = zbuf + 32;
    const int lgB = (B == 8) ? 3 : 1, cbw = 2048 >> lgB;
#pragma unroll 1
    for (int c = blockIdx.x; c < 256; c += G) {
        for (int e = tid; e < MH / 8; e += 512) *(u32x4*)(vbuf + e * 8) = *(const u32x4*)(vT + (size_t)c * MH + e * 8);
        if (tid < 4) *(u32x4*)(zbuf + tid * 8) = (u32x4){0u, 0u, 0u, 0u};
        for (int e = tid; e < (2 * L + 64) / 8; e += 512) *(u32x4*)(gbuf + e * 8) = *(const u32x4*)(Gf + (size_t)c * GLEN + e * 8);
        __syncthreads();
        const int T0 = 2 * wid * cbw, bq = fr & (B - 1), sgm = fr >> lgB;
        const int tc0 = T0 + 128 * sgm, tc1 = tc0 + cbw;
        f32x4 acc[8][2];
#pragma unroll
        for (int r = 0; r < 8; ++r) { acc[r][0] = (f32x4){0.f, 0.f, 0.f, 0.f}; acc[r][1] = (f32x4){0.f, 0.f, 0.f, 0.f}; }
        const bf16_t* ga = gbuf + 32 + L - 8 * fr + 8 * fq - 8;
        const bf16_t* vrow = vbuf + bq * L + 8 * fq;
        const unsigned lim = (unsigned)(L - 32);
        const int Dlo = T0 - L + 32, Dhi = T0 + 2 * cbw - 128;
#define HY_LOAD(SET, Dv) do { const int D_ = (Dv); \
            WL[SET] = *(const u32x4*)(ga - D_); WH[SET] = *(const u32x4*)(ga - D_ + 8); \
            { const int s0_ = tc0 - D_, s1_ = tc1 - D_; \
              BV[SET][0] = *(const pg8::bf16x8*)(((unsigned)s0_ <= lim) ? (vrow + s0_) : (zbuf + 8 * fq)); \
              BV[SET][1] = *(const pg8::bf16x8*)(((unsigned)s1_ <= lim) ? (vrow + s1_) : (zbuf + 8 * fq)); } } while (0)
#define HY_MMA(SET) do { const unsigned w0_ = WL[SET].x, w1_ = WL[SET].y, w2_ = WL[SET].z, w3_ = WL[SET].w, w4_ = WH[SET].x, w5_ = WH[SET].y, w6_ = WH[SET].z, w7_ = WH[SET].w; \
            const unsigned x0_ = __builtin_amdgcn_alignbit(w1_, w0_, 16), x1_ = __builtin_amdgcn_alignbit(w2_, w1_, 16), x2_ = __builtin_amdgcn_alignbit(w3_, w2_, 16), x3_ = __builtin_amdgcn_alignbit(w4_, w3_, 16), \
                           x4_ = __builtin_amdgcn_alignbit(w5_, w4_, 16), x5_ = __builtin_amdgcn_alignbit(w6_, w5_, 16), x6_ = __builtin_amdgcn_alignbit(w7_, w6_, 16); \
            pg8::bf16x8 A_[8]; \
            A_[0] = __builtin_bit_cast(pg8::bf16x8, (u32x4){w4_, w5_, w6_, w7_}); A_[1] = __builtin_bit_cast(pg8::bf16x8, (u32x4){x3_, x4_, x5_, x6_}); \
            A_[2] = __builtin_bit_cast(pg8::bf16x8, (u32x4){w3_, w4_, w5_, w6_}); A_[3] = __builtin_bit_cast(pg8::bf16x8, (u32x4){x2_, x3_, x4_, x5_}); \
            A_[4] = __builtin_bit_cast(pg8::bf16x8, (u32x4){w2_, w3_, w4_, w5_}); A_[5] = __builtin_bit_cast(pg8::bf16x8, (u32x4){x1_, x2_, x3_, x4_}); \
            A_[6] = __builtin_bit_cast(pg8::bf16x8, (u32x4){w1_, w2_, w3_, w4_}); A_[7] = __builtin_bit_cast(pg8::bf16x8, (u32x4){x0_, x1_, x2_, x3_}); \
            _Pragma("unroll") for (int r = 0; r < 8; ++r) { \
                acc[r][0] = __builtin_amdgcn_mfma_f32_16x16x32_bf16(A_[r], BV[SET][0], acc[r][0], 0, 0, 0); \
                acc[r][1] = __builtin_amdgcn_mfma_f32_16x16x32_bf16(A_[r], BV[SET][1], acc[r][1], 0, 0, 0); } } while (0)
        u32x4 WL[2], WH[2]; pg8::bf16x8 BV[2][2];
        HY_LOAD(0, Dlo);
#pragma unroll 1
        for (int D = Dlo; D <= Dhi; D += 64) {
            HY_LOAD(1, D + 32);
            __builtin_amdgcn_sched_barrier(0);
            __builtin_amdgcn_s_setprio(1); HY_MMA(0); __builtin_amdgcn_s_setprio(0);
            __builtin_amdgcn_sched_barrier(0);
            HY_LOAD(0, D + 64);
            __builtin_amdgcn_sched_barrier(0);
            __builtin_amdgcn_s_setprio(1); HY_MMA(1); __builtin_amdgcn_s_setprio(0);
            __builtin_amdgcn_sched_barrier(0);
        }
#undef HY_LOAD
#undef HY_MMA
#pragma unroll
        for (int cb = 0; cb < 2; ++cb) { float* yo = yT + (size_t)c * MH + (size_t)bq * L + (cb ? tc1 : tc0) + 32 * fq;
#pragma unroll
            for (int j = 0; j < 4; ++j) { *(f32x4*)(yo + 8 * j) = (f32x4){acc[0][cb][j], acc[1][cb][j], acc[2][cb][j], acc[3][cb][j]}; *(f32x4*)(yo + 8 * j + 4) = (f32x4){acc[4][cb][j], acc[5][cb][j], acc[6][cb][j], acc[7][cb][j]}; } }
        __syncthreads();
    }
}

__device__ __forceinline__ void hg_chain_naive(const P& p, unsigned char* lds, int l, int b, int h, int dir, int L) {
    int tid_ = threadIdx.x; asm volatile("" : "+v"(tid_)); OPQ_Z const int tid = tid_, dv = tid & 127, kq = __builtin_amdgcn_readfirstlane(tid >> 7);
    const bf16_t* __restrict__ ub = (const bf16_t*)(PWS + WS_U); bf16_t* __restrict__ ob = (bf16_t*)(PWS + (dir ? WS_OB : WS_OF));
    float* fs = (float*)lds; float* ks = fs + 128; float* qs = ks + 128; float* op = qs + 128;
    const float lbv = ((const float*)(PWS + WS_LB))[(dir * 2 + l) * 512 + h * 128 + dv];
    float S[32];
#pragma unroll
    for (int i = 0; i < 32; ++i) S[i] = 0.f;
    const int zoff = (dir ? 2304 : 1792) + h * 128 + dv, qoff = 768 + h * 128 + dv, voff = 1280 + h * 128 + dv;
    size_t row = (size_t)b * L + (dir ? L - 1 : 0);
    bf16_t zn = ub[row * DIN + zoff], qn = ub[row * DIN + qoff], vn = ub[row * DIN + voff];
#pragma unroll 1
    for (int step = 0; step < L; ++step) {
        const size_t crow = row; const float z = bf2f(zn), q = bf2f(qn), v = bf2f(vn);
        if (step + 1 < L) { row = dir ? row - 1 : row + 1; zn = ub[row * DIN + zoff]; qn = ub[row * DIN + qoff]; vn = ub[row * DIN + voff]; }
        if (tid < 128) { const float sg = sigm(z); fs[tid] = lbv + (1.0f - lbv) * sg; ks[tid] = (1.0f - lbv) * (1.0f - sg); qs[tid] = q; }
        __syncthreads();
        float o = 0.f;
#pragma unroll
        for (int i = 0; i < 32; ++i) { const int k = kq * 32 + i; S[i] = fs[k] * S[i] + ks[k] * v; o += S[i] * qs[k]; }
        op[kq * 128 + dv] = o;
        __syncthreads();
        if (tid < 128) ob[crow * 512 + h * 128 + tid] = f2bf(op[tid] + op[128 + tid] + op[256 + tid] + op[384 + tid]);
    }
    __syncthreads();
}


__device__ __forceinline__ void mix_phase(const P& p, unsigned char* lds, int l, int B, int L) {
    const int G = opq_grid(), bid = blockIdx.x;
    rg_carry(p, B, L);
#ifdef HG_NAIVE
#pragma unroll 1
    for (int it = bid; it < B * 8; it += G) hg_chain_naive(p, lds, l, it >> 3, (it >> 1) & 3, it & 1, L);
#else
    { int t2_ = threadIdx.x; asm volatile("" : "+v"(t2_));
#pragma unroll 1
      for (int it = bid; it < 256; it += G) HGSEG<true>(p, lds, l, it, L, t2_);
#ifdef DUP_HG
      for (int it = bid; it < 256; it += G) HGSEG<true>(p, lds, l, it, L, t2_);
#endif
    }
#endif
#ifdef HY_NAIVE
    hy_conv_naive(p, lds, B, L);
#else
    hy_conv_mfma(p, lds, B, L);
#ifdef DUP_HY
    hy_conv_mfma(p, lds, B, L);
#endif
#endif
}

__device__ __forceinline__ void post_phase(const P& p, unsigned char* lds, int l, int B, int L) {
    int tid_ = threadIdx.x; asm volatile("" : "+v"(tid_)); OPQ_Z const int tid = tid_, lane = tid & 63, wid = tid >> 6, G = opq_grid();
    const bf16_t* __restrict__ ub = (const bf16_t*)(PWS + WS_U); const float* __restrict__ yT = (const float*)(PWS + WS_YT);
    const bf16_t* __restrict__ of = (const bf16_t*)(PWS + WS_OF); const bf16_t* __restrict__ obk = (const bf16_t*)(PWS + WS_OB);
    bf16_t* __restrict__ yb = (bf16_t*)(PWS + WS_H);
    float* sy = (float*)lds;
    const float* cw = PIN(12) + l * 3 * 768; const float* cb = PIN(13) + l * 768; const float* hbias = PIN(22) + l * 256; const float* gain = PIN(6) + l * 1024;
#pragma unroll 1
    for (int tile = blockIdx.x; tile < MH / 64; tile += G) {
        const int r0 = tile * 64, rowb = (r0 / L) * L, t0 = r0 - rowb;
#pragma unroll 4
        for (int e = tid; e < 256 * 16; e += 512) { const int c = e >> 4, t4 = (e & 15) * 4; const f32x4 yv = *(const f32x4*)(yT + (size_t)c * MH + r0 + t4);
            sy[t4 * 257 + c] = yv[0]; sy[(t4 + 1) * 257 + c] = yv[1]; sy[(t4 + 2) * 257 + c] = yv[2]; sy[(t4 + 3) * 257 + c] = yv[3]; }
        __syncthreads();
#pragma unroll 2
        for (int r = 0; r < 4; ++r) {
            const int t = 2 * (wid + 8 * r) + (lane >> 5), tok = t0 + t, c0 = (lane & 31) * 8; const size_t row = (size_t)(r0 + t);
            float cv[3][8];
#pragma unroll
            for (int g = 0; g < 3; ++g) { const f32x4 b0 = *(const f32x4*)(cb + g * 256 + c0), b1 = *(const f32x4*)(cb + g * 256 + c0 + 4);
#pragma unroll
                for (int e = 0; e < 4; ++e) { cv[g][e] = b0[e]; cv[g][4 + e] = b1[e]; } }
#pragma unroll
            for (int k2 = 0; k2 < 3; ++k2) { const int tt = tok + k2 - 1;
                if (tt >= 0 && tt < L) {
#pragma unroll
                    for (int g = 0; g < 3; ++g) { const u32x4 xa = *(const u32x4*)(ub + (row + k2 - 1) * DIN + g * 256 + c0); const float* wa = cw + k2 * 768 + g * 256 + c0;
                        const f32x4 a0 = *(const f32x4*)wa, a1 = *(const f32x4*)(wa + 4);
                        cv[g][0] += a0[0] * lo16(xa.x); cv[g][1] += a0[1] * hi16(xa.x); cv[g][2] += a0[2] * lo16(xa.y); cv[g][3] += a0[3] * hi16(xa.y);
                        cv[g][4] += a1[0] * lo16(xa.z); cv[g][5] += a1[1] * hi16(xa.z); cv[g][6] += a1[2] * lo16(xa.w); cv[g][7] += a1[3] * hi16(xa.w); } } }
            float y[8], ss = 0.f;
            { const f32x4 h0 = *(const f32x4*)(hbias + c0), h1 = *(const f32x4*)(hbias + c0 + 4);
#pragma unroll
              for (int e = 0; e < 8; ++e) { const float v = cv[2][e] * cv[1][e]; y[e] = (sy[t * 257 + c0 + e] + v * (e < 4 ? h0[e & 3] : h1[e & 3])) * cv[0][e]; ss += y[e] * y[e]; } }
            ss += __shfl_xor(ss, 16); ss += __shfl_xor(ss, 8); ss += __shfl_xor(ss, 4); ss += __shfl_xor(ss, 2); ss += __shfl_xor(ss, 1);
            const float rstd = rsqrtf(ss * (1.0f / 256.0f) + EPSN); const f32x4 g0 = *(const f32x4*)(gain + c0), g1 = *(const f32x4*)(gain + c0 + 4);
            u32x4 o; o.x = pk2(y[0] * rstd * g0[0], y[1] * rstd * g0[1]); o.y = pk2(y[2] * rstd * g0[2], y[3] * rstd * g0[3]); o.z = pk2(y[4] * rstd * g1[0], y[5] * rstd * g1[1]); o.w = pk2(y[6] * rstd * g1[2], y[7] * rstd * g1[3]);
            *(u32x4*)(yb + row * DM + c0) = o;
        }
#pragma unroll 4
        for (int r = 0; r < 8; ++r) { const int t = wid + 8 * r; const size_t row = (size_t)(r0 + t);
            { const u32x4 a = *(const u32x4*)(of + row * 512 + lane * 8), b = *(const u32x4*)(obk + row * 512 + lane * 8), gw = *(const u32x4*)(ub + row * DIN + 2816 + lane * 8);
              float o8[8] = {lo16(a.x) + lo16(b.x), hi16(a.x) + hi16(b.x), lo16(a.y) + lo16(b.y), hi16(a.y) + hi16(b.y), lo16(a.z) + lo16(b.z), hi16(a.z) + hi16(b.z), lo16(a.w) + lo16(b.w), hi16(a.w) + hi16(b.w)};
              const float g8[8] = {lo16(gw.x), hi16(gw.x), lo16(gw.y), hi16(gw.y), lo16(gw.z), hi16(gw.z), lo16(gw.w), hi16(gw.w)};
              float s2 = 0.f;
#pragma unroll
              for (int e = 0; e < 8; ++e) s2 += o8[e] * o8[e];
              s2 += __shfl_xor(s2, 1); s2 += __shfl_xor(s2, 2); s2 += __shfl_xor(s2, 4); s2 += __shfl_xor(s2, 8);
              const float rstd = rsqrtf(s2 * (1.0f / 128.0f) + EPSN); const float* gn = gain + 256 + lane * 8;
#pragma unroll
              for (int e = 0; e < 8; ++e) { const float gg = g8[e]; o8[e] = o8[e] * rstd * gn[e] * (gg * sigm(gg)); }
              u32x4 o; o.x = pk2(o8[0], o8[1]); o.y = pk2(o8[2], o8[3]); o.z = pk2(o8[4], o8[5]); o.w = pk2(o8[6], o8[7]);
              *(u32x4*)(yb + row * DM + 256 + lane * 8) = o; }
        }
        __syncthreads();
    }
    int tid2_ = threadIdx.x; asm volatile("" : "+v"(tid2_)); const int tid2 = tid2_;
    pg8::bf16x8 Bw[8][2]; RgPrm prm; RG_LOAD_W(p, l, tid2, Bw, prm);
#pragma unroll 1
    for (int tile = blockIdx.x; tile < MH / 32; tile += G) {
        const int r0 = tile * 32, rowb = (r0 / L) * L, t0 = r0 - rowb;
        rg_tile<true>(p, lds, l, rowb, L, t0, ub, yb, Bw, prm, tid2);
    }
#ifdef DUP_RGC
#pragma unroll 1
    for (int tile = blockIdx.x; tile < MH / 32; tile += G) {
        const int r0 = tile * 32, rowb = (r0 / L) * L, t0 = r0 - rowb;
        rg_tile<true>(p, lds, l, rowb, L, t0, ub, yb, Bw, prm, tid2);
    }
#endif
}

#ifdef DUP_SYNC
#define GSYNC() do { xcd_barrier(xbar); xcd_barrier(xbar); } while (0)
#else
#define GSYNC() xcd_barrier(xbar)
#endif
__global__ void __launch_bounds__(512, 2) hymba_fwd(P p) {
    extern __shared__ __attribute__((aligned(16))) unsigned char lds[];
    cg::grid_group grid = cg::this_grid();
    OPQ_Z
    if (threadIdx.x < 4) ((unsigned*)(lds + LDS_BYTES - 16))[threadIdx.x] = 0u;
    __syncthreads();
    const XcdBarrier xbar = xcd_barrier_post((unsigned*)(PWS + WS_BAR), (volatile LAS unsigned*)(lds + LDS_BYTES - 16));
    const int G = opq_grid(), bid = blockIdx.x;
    bf16_t* hbuf = (bf16_t*)(PWS + WS_H); bf16_t* ubuf = (bf16_t*)(PWS + WS_U);
    const float* mod = (const float*)(PWS + WS_MOD);
#ifndef NO_INIT
    init_phase(p, lds);
#ifdef DUP_INIT
    init_phase(p, lds);
#endif
#endif
    int oK1 = DM, oK2 = DFF, oN1 = DIN, oN2 = DM, oN3 = 2 * DFF, oM = MH;
    asm volatile("" : "+s"(oK1), "+s"(oK2), "+s"(oN1), "+s"(oN2), "+s"(oN3), "+s"(oM));
    grid.sync();
#pragma unroll 1
    for (int half = 0; half < 2; ++half) {
        const int B = half ? 2 : 8, L = half ? 16384 : 4096, lshift = half ? 14 : 12, rbase = half ? 8 : 0;
        const float* xin = PIN(half); float* xres = POUT + (size_t)half * MH * DM;
#pragma unroll 1
        for (int l = 0; l < 2; ++l) {
            const float* xcur = l == 0 ? xin : xres;
            const float* modl = mod + (size_t)l * 10 * 6144;
#ifndef NO_NORM
            norm_mod(xcur, PIN(9) + l * DM, modl, 1024, 0, rbase, lshift, hbuf);
#endif
#ifndef NO_FILT
            filter_gen(p, lds, l, L);
#ifdef DUP_FILT
            filter_gen(p, lds, l, L);
#endif
#endif
            GSYNC();
#ifndef NO_G1
            { pg8::Gemm g{hbuf, (const bf16_t*)(PWS + WS_WIN) + (size_t)l * DIN * DM, oM, oN1, oK1}; pg8::StaticOrder S; S.init(oM, oN1, G, bid); EpiB16 E{ubuf, DIN};
              pg8::gemm_phase<EpiB16, pg8::StaticOrder>((LDSP unsigned char*)lds, g, S, E, nullptr);
#ifdef DUP_G1
              pg8::gemm_phase<EpiB16, pg8::StaticOrder>((LDSP unsigned char*)lds, g, S, E, nullptr);
#endif
            }
#endif
            GSYNC();
#ifndef NO_PREP
            prep_phase(p, lds, l, B, L);
#ifdef DUP_PREP
            prep_phase(p, lds, l, B, L);
#endif
#endif
            GSYNC();
#ifndef NO_MIX
            mix_phase(p, lds, l, B, L);
#endif
            GSYNC();
#ifndef NO_POST
            post_phase(p, lds, l, B, L);
#ifdef DUP_POST
            post_phase(p, lds, l, B, L);
#endif
#endif
            GSYNC();
#ifndef NO_G2
            { pg8::Gemm g{hbuf, (const bf16_t*)(PWS + WS_WOUT) + (size_t)l * DM * DM, oM, oN2, oK1}; pg8::StaticOrder S; S.init(oM, oN2, G, bid); EpiRes E{xcur, xres, modl + (size_t)rbase * 6144 + 2048, lshift};
              pg8::gemm_phase<EpiRes, pg8::StaticOrder>((LDSP unsigned char*)lds, g, S, E, nullptr); }
#endif
            GSYNC();
            norm_mod(xres, PIN(10) + l * DM, modl, 4096, 3072, rbase, lshift, hbuf);
            GSYNC();
#ifndef NO_G3
            { pg8::Gemm g{hbuf, (const bf16_t*)(PWS + WS_WGU) + (size_t)l * 2 * DFF * DM, oM, oN3, oK1}; pg8::StaticOrder S; S.init(oM, oN3, G, bid); EpiSwi E{ubuf};
              pg8::gemm_phase<EpiSwi, pg8::StaticOrder>((LDSP unsigned char*)lds, g, S, E, nullptr);
#ifdef DUP_G3
              pg8::gemm_phase<EpiSwi, pg8::StaticOrder>((LDSP unsigned char*)lds, g, S, E, nullptr);
#endif
            }
#endif
            GSYNC();
#ifndef NO_G4
            { pg8::Gemm g{ubuf, (const bf16_t*)(PWS + WS_WD) + (size_t)l * DM * DFF, oM, oN2, oK2}; pg8::StaticOrder S; S.init(oM, oN2, G, bid); EpiRes E{xres, xres, modl + (size_t)rbase * 6144 + 5120, lshift};
              pg8::gemm_phase<EpiRes, pg8::StaticOrder>((LDSP unsigned char*)lds, g, S, E, nullptr); }
#endif
            GSYNC();
        }
        final_norm(xres, PIN(11));
    }
}

extern "C" void kernel_launch(void* const* d_in, const int* in_sizes, int n_in, void* d_out, int out_size, void* d_ws, size_t ws_size, hipStream_t stream) {
    static int grid = 0;
    if (grid == 0) {
        int dev = 0, cus = 0, per_cu = 0;
        hipGetDevice(&dev); hipDeviceGetAttribute(&cus, hipDeviceAttributeMultiprocessorCount, dev);
        hipFuncSetAttribute((const void*)hymba_fwd, hipFuncAttributeMaxDynamicSharedMemorySize, LDS_BYTES);
        hipOccupancyMaxActiveBlocksPerMultiprocessor(&per_cu, (const void*)hymba_fwd, 512, LDS_BYTES);
        if (per_cu < 1) per_cu = 1;
        grid = cus * per_cu;
        if (n_in != 34 || ws_size < WS_NEED) { fprintf(stderr, "kernel_launch: unexpected n_in %d / ws %zu\n", n_in, ws_size); }
    }
    P p{};
    for (int i = 0; i < 34; ++i) p.ptr[i] = d_in[i];
    p.ptr[34] = d_out; p.ptr[35] = d_ws;
    (void)hipMemsetAsync((unsigned char*)d_ws + WS_BAR, 0, 16384, stream);
    void* args[] = {&p};
    hipError_t e = hipLaunchCooperativeKernel((const void*)hymba_fwd, dim3(grid), dim3(512), args, LDS_BYTES, stream);
    if (e != hipSuccess) fprintf(stderr, "cooperative launch failed: %s (grid %d)\n", hipGetErrorString(e), grid);
}
```

```cpp
#include <hip/hip_runtime.h>
#include <hip/hip_cooperative_groups.h>
#include <cstdio>
namespace cg = cooperative_groups;
namespace pg8 {
#define PG8_LAS __attribute__((address_space(3)))
typedef unsigned short bf16_t;
typedef short bf16x8 __attribute__((ext_vector_type(8)));
typedef float f32x4 __attribute__((ext_vector_type(4)));
typedef unsigned u32x4 __attribute__((ext_vector_type(4)));
constexpr int BM = 256, BK = 64, HALF = 128, HTB = HALF * BK * 2  , STAGE_BYTES = 8 * HTB, NXCD = 8, WGM = 8;

__host__ __device__ __forceinline__ int lds_byte(int r, int c) { const int st = (r >> 4) * 2 + (c >> 5), rr = r & 15, cc = c & 31, ob = rr * 64 + cc * 2; return st * 1024 + (ob ^ (((ob >> 9) & 1) << 5)); }
__host__ __device__ __forceinline__ void stage_rc(int b, int& R, int& C) { const int st = b / 1024, sb = b % 1024, swz = sb ^ (((sb >> 9) & 1) << 5); R = (st >> 1) * 16 + swz / 64; C = (st & 1) * 32 + (swz % 64) / 2; }
__host__ __device__ __forceinline__ int perm32(int rho) { const int n = rho >> 4, i = rho & 15; return 8 * (i >> 2) + 4 * n + (i & 3); }

struct Unit { int pm, pn; };
struct Gemm { const bf16_t* A; const bf16_t* Bt; int M, N, K; };

struct StaticOrder {
    int nM, nN, nwg, G, c;
    __host__ __device__ void init(int M, int N, int G_, int c_) { nM = M / BM; nN = N / BM; nwg = nM * nN; G = G_; c = c_; }
    __host__ __device__ bool next(int i, Unit& u) const {
        const long L = (long)i * G + c; if (L >= nwg) return false;
        int wgid = (int)L; { const int q = nwg / NXCD, r = nwg % NXCD, xcd = wgid % NXCD, off = wgid / NXCD; wgid = (xcd < r ? xcd * (q + 1) : r * (q + 1) + (xcd - r) * q) + off; }
        const int nig = WGM * nN, gid = wgid / nig, fm = gid * WGM, gsz = (nM - fm) < WGM ? (nM - fm) : WGM;
        u.pm = fm + ((wgid % nig) % gsz); u.pn = (wgid % nig) / gsz; return true;
    }
    __device__ __forceinline__ void a_ready(const Unit&) const {}
    __device__ __forceinline__ void done(const Unit&) const {}
};
__device__ __forceinline__ unsigned cvt_pk_bf16(float lo, float hi) { unsigned r; asm volatile("v_cvt_pk_bf16_f32 %0, %1, %2" : "=v"(r) : "v"(lo), "v"(hi)); return r; }
typedef float f32x2 __attribute__((ext_vector_type(2)));
template <class Epi, class Sched, bool STAMP = false>
__device__ __forceinline__ void gemm_phase(PG8_LAS unsigned char* lds, const Gemm g, const Sched& S, const Epi& E, unsigned long long* stamps) {
    int tid_ = threadIdx.x; asm volatile("" : "+v"(tid_)); const int tid = tid_, wid = __builtin_amdgcn_readfirstlane(tid >> 6), lane = tid & 63, wr = wid >> 2, wc = wid & 3, fr = lane & 15, fq = lane >> 4;
    const int K = g.K, nt = K / BK;
    int ts_lo = 0, ts_hi = 0, nts = 0; const unsigned long long rt_entry = STAMP ? (unsigned long long)wall_clock64() : 0ull;
#define PG8_STAMP() do { if (STAMP && wid == 0 && nts < 64) { const unsigned long long _c = (unsigned long long)clock64(); \
        ts_lo = (lane == nts) ? (int)(unsigned)_c : ts_lo; ts_hi = (lane == nts) ? (int)(unsigned)(_c >> 32) : ts_hi; ++nts; } } while (0)
    PG8_STAMP();
    unsigned voffA[2], voffB[2];
#pragma unroll
    for (int i = 0; i < 2; ++i) { int R, C; stage_rc(tid * 16 + i * 8192, R, C); const int Rb = Epi::PERM ? ((R & ~31) + perm32(R & 31)) : R;
        voffA[i] = (unsigned)(R * K + C) * 2u; voffB[i] = (unsigned)(Rb * K + C) * 2u; }
    const size_t kstep = (size_t)(BK * 2);
    const size_t hstep = (size_t)HALF * K * 2;
    const size_t tstep = 2 * hstep;
    const unsigned ldsw = (unsigned)wid * 1024u;
    const int aoff = lds_byte(wr * 64 + fr, fq * 8), boff = lds_byte(wc * 32 + fr, fq * 8);
#define PG8_SA(b, h) (((b) * 2 + (h)) * HTB)
#define PG8_SB(b, h) ((4 + (b) * 2 + (h)) * HTB)
#define PG8_STAGE(bufoff, gbase, voff) do { _Pragma("unroll") for (int _i = 0; _i < 2; ++_i) \
        __builtin_amdgcn_global_load_lds((const unsigned*)((const char*)(gbase) + (voff)[_i]), (PG8_LAS unsigned*)(lds + (bufoff) + ldsw + _i * 8192), 16, 0, 0); } while (0)
#define PG8_LDA(dst, b, h) do { _Pragma("unroll") for (int m = 0; m < 4; ++m) _Pragma("unroll") for (int k = 0; k < 2; ++k) dst[m][k] = *(const PG8_LAS bf16x8*)(lds + PG8_SA(b, h) + aoff + m * 2048 + k * 1024); } while (0)
#define PG8_LDB(dst, b, h) do { _Pragma("unroll") for (int n = 0; n < 2; ++n) _Pragma("unroll") for (int k = 0; k < 2; ++k) dst[n][k] = *(const PG8_LAS bf16x8*)(lds + PG8_SB(b, h) + boff + n * 2048 + k * 1024); } while (0)
#define PG8_MMA(ai, bj, At, Bt) do { __builtin_amdgcn_s_setprio(1); _Pragma("unroll") for (int m = 0; m < 4; ++m) _Pragma("unroll") for (int n = 0; n < 2; ++n) _Pragma("unroll") for (int k = 0; k < 2; ++k) \
        acc[ai][bj][m][n] = __builtin_amdgcn_mfma_f32_16x16x32_bf16(Bt[n][k], At[m][k], acc[ai][bj][m][n], 0, 0, 0); __builtin_amdgcn_s_setprio(0); } while (0)
#define PG8_WAIT_V(n) asm volatile("s_waitcnt vmcnt(" #n ")" ::: "memory")
#define PG8_WAIT_L(n) asm volatile("s_waitcnt lgkmcnt(" #n ")" ::: "memory")
#define PG8_BAR __builtin_amdgcn_s_barrier()
#define PG8_SCHED __builtin_amdgcn_sched_barrier(0)
    Unit cur, nxt; int ui = 0;
    if (!S.next(0, cur)) return;
    f32x4 acc[2][2][4][2];
#pragma unroll
    for (int a = 0; a < 2; ++a)
#pragma unroll
        for (int b = 0; b < 2; ++b)
#pragma unroll
            for (int m = 0; m < 4; ++m)
#pragma unroll
                for (int n = 0; n < 2; ++n) acc[a][b][m][n] = (f32x4){0.f, 0.f, 0.f, 0.f};
    bf16x8 At[4][2], B0[2][2], B1[2][2];
    const char* cA = (const char*)g.A + (size_t)cur.pm * tstep; const char* cB = (const char*)g.Bt + (size_t)cur.pn * tstep;
    S.a_ready(cur);
    PG8_STAGE(PG8_SB(0, 0), cB, voffB); PG8_STAGE(PG8_SA(0, 0), cA, voffA); PG8_STAGE(PG8_SB(0, 1), cB + hstep, voffB); PG8_STAGE(PG8_SA(0, 1), cA + hstep, voffA);
    if (wr == 1) PG8_BAR;
    PG8_WAIT_V(4); PG8_BAR;
    PG8_STAGE(PG8_SB(1, 0), cB + kstep, voffB); PG8_STAGE(PG8_SA(1, 0), cA + kstep, voffA); PG8_STAGE(PG8_SB(1, 1), cB + hstep + kstep, voffB);
    PG8_WAIT_V(6); PG8_BAR;
    PG8_STAMP();
    for (;;) {
        const bool has_next = S.next(ui + 1, nxt);
        const char* nA = has_next ? (const char*)g.A + (size_t)nxt.pm * tstep : cA; const char* nB = has_next ? (const char*)g.Bt + (size_t)nxt.pn * tstep : cB;
        for (int t = 0; t < nt; t += 2) {
            const bool last = (t == nt - 2);
            const char* a1 = cA + (size_t)(t + 1) * kstep;
            const char* a2 = last ? nA : cA + (size_t)(t + 2) * kstep; const char* b2 = last ? nB : cB + (size_t)(t + 2) * kstep;
            const char* a3 = a2 + kstep; const char* b3 = b2 + kstep;
            if (last && has_next) S.a_ready(nxt);
            PG8_LDB(B0, 0, 0); PG8_SCHED; PG8_LDA(At, 0, 0); PG8_STAGE(PG8_SA(1, 1), a1 + hstep, voffA);
            PG8_WAIT_L(8); PG8_BAR; PG8_WAIT_L(0); PG8_MMA(0, 0, At, B0); PG8_BAR; PG8_SCHED;
            PG8_LDB(B1, 0, 1); PG8_STAGE(PG8_SB(0, 0), b2, voffB);
            PG8_BAR; PG8_WAIT_L(0); PG8_MMA(0, 1, At, B1); PG8_BAR;
            PG8_LDA(At, 0, 1); PG8_STAGE(PG8_SA(0, 0), a2, voffA);
            PG8_BAR; PG8_WAIT_L(0); PG8_MMA(1, 0, At, B0); PG8_BAR; PG8_SCHED;
            PG8_STAGE(PG8_SB(0, 1), b2 + hstep, voffB);
            PG8_WAIT_V(6); PG8_BAR; PG8_MMA(1, 1, At, B1); PG8_BAR;
            PG8_LDB(B0, 1, 0); PG8_SCHED; PG8_LDA(At, 1, 0); PG8_STAGE(PG8_SA(0, 1), a2 + hstep, voffA);
            PG8_WAIT_L(8); PG8_BAR; PG8_WAIT_L(0); PG8_MMA(0, 0, At, B0); PG8_BAR; PG8_SCHED;
            PG8_LDB(B1, 1, 1); PG8_STAGE(PG8_SB(1, 0), b3, voffB);
            PG8_BAR; PG8_WAIT_L(0); PG8_MMA(0, 1, At, B1); PG8_BAR;
            PG8_LDA(At, 1, 1); PG8_STAGE(PG8_SA(1, 0), a3, voffA);
            PG8_BAR; PG8_WAIT_L(0); PG8_MMA(1, 0, At, B0); PG8_BAR; PG8_SCHED;
            PG8_STAGE(PG8_SB(1, 1), b3 + hstep, voffB);
            PG8_WAIT_V(6); PG8_BAR; PG8_MMA(1, 1, At, B1); PG8_BAR;
        }
        PG8_STAMP();
        if constexpr (!Epi::AFTER_DRAIN) { E(acc, cur, wr, wc, fr, fq); S.done(cur); }
        PG8_STAMP();
        if (!has_next) break;
#pragma unroll
        for (int a = 0; a < 2; ++a)
#pragma unroll
            for (int b = 0; b < 2; ++b)
#pragma unroll
                for (int m = 0; m < 4; ++m)
#pragma unroll
                    for (int n = 0; n < 2; ++n) acc[a][b][m][n] = (f32x4){0.f, 0.f, 0.f, 0.f};
        cur = nxt; cA = nA; cB = nB; ++ui;
    }
    PG8_WAIT_V(0);
    if (wr == 0) PG8_BAR;
    PG8_BAR;
    if constexpr (Epi::AFTER_DRAIN) { E.fused(acc, cur, wr, wc, fr, fq, lds, wid, lane); S.done(cur); }
    PG8_STAMP();
    if (STAMP && wid == 0) { stamps[lane] = lane < nts ? (((unsigned long long)(unsigned)ts_hi << 32) | (unsigned)ts_lo) : 0ull;
        if (lane == 62) stamps[62] = rt_entry; if (lane == 63) stamps[63] = (unsigned long long)wall_clock64(); }
#undef PG8_STAMP
#undef PG8_SA
#undef PG8_SB
#undef PG8_STAGE
#undef PG8_LDA
#undef PG8_LDB
#undef PG8_MMA
#undef PG8_WAIT_V
#undef PG8_WAIT_L
#undef PG8_BAR
#undef PG8_SCHED
}
}
#define XB_TMO      128
#define XB_XCNT(j)  (256  + 64 * (j))
#define XB_XSUB(j)  (1280 + 64 * (j))
#define XB_XGEN(j)  (2304 + 64 * (j))
#define XB_TOP      3328
#define XB_TOPGEN   3392
#define XCD_BAR_WORDS 3456
#define XB_SPIN_CAP (1u << 18)
#define LAS __attribute__((address_space(3)))

__device__ __forceinline__ unsigned xb_ld(unsigned* p)              { return __hip_atomic_load(p, __ATOMIC_RELAXED, __HIP_MEMORY_SCOPE_AGENT); }
__device__ __forceinline__ unsigned xb_add(unsigned* p, unsigned v) { return __hip_atomic_fetch_add(p, v, __ATOMIC_RELAXED, __HIP_MEMORY_SCOPE_AGENT); }
__device__ __forceinline__ unsigned xb_xcc_id() { return (unsigned)__builtin_amdgcn_s_getreg((3 << 11) | 20) & 0xFu; }
#define XB_SPIN(cond, bar) do { unsigned _sp = 0; while (cond) { __builtin_amdgcn_s_sleep(1); \
    if ((++_sp & 255u) == 0u) { if (xb_ld(&(bar)[XB_TMO])) break; if (_sp > XB_SPIN_CAP) { atomicAdd(&(bar)[XB_TMO], 1u); break; } } } } while (0)

struct XcdBarrier {
    unsigned* bar; unsigned x;
    volatile LAS unsigned* st;
};

__device__ __forceinline__ XcdBarrier xcd_barrier_post(unsigned* bar, volatile LAS unsigned* st) {
    XcdBarrier b; b.bar = bar; b.x = xb_xcc_id(); b.st = st;
    if (threadIdx.x == 0) (void)xb_add(&bar[XB_XCNT(b.x)], 1u);
    return b;
}
__device__ __forceinline__ void xcd_barrier_complete(unsigned* bar, unsigned x, unsigned& nloc, unsigned& nx) {
    const unsigned G = gridDim.x * gridDim.y * gridDim.z;
    unsigned sum, cnt, mine, sp = 0u;
    for (;;) {
        sum = 0u; cnt = 0u; mine = 0u;
#pragma unroll
        for (unsigned j = 0; j < 16; ++j) { const unsigned c = xb_ld(&bar[XB_XCNT(j)]); sum += c; cnt += (c > 0u) ? 1u : 0u; mine = (j == x) ? c : mine; }
        if (sum == G) break;
        __builtin_amdgcn_s_sleep(1);
        if ((++sp & 255u) == 0u) { if (xb_ld(&bar[XB_TMO])) break; if (sp > XB_SPIN_CAP) { atomicAdd(&bar[XB_TMO], 1u); break; } }
    }
    nloc = mine > 0u ? mine : 1u; nx = cnt > 0u ? cnt : 1u;
}

__device__ __forceinline__ void xcd_barrier(const XcdBarrier& b) {
    asm volatile("s_waitcnt vmcnt(0)" ::: "memory");
    __syncthreads();
    if (threadIdx.x == 0) {
        unsigned* bar = b.bar;
        __builtin_amdgcn_s_waitcnt(0);
        unsigned nloc = b.st[0], nx = b.st[1];
        if (nloc == 0u) { xcd_barrier_complete(bar, b.x, nloc, nx); b.st[0] = nloc; b.st[1] = nx; }
        const unsigned old = xb_add(&bar[XB_XSUB(b.x)], 1u);
        const unsigned gen = old / nloc;
        if (old + 1u == (gen + 1u) * nloc) {
            __builtin_amdgcn_fence(__ATOMIC_RELEASE, "agent");
            asm volatile("s_waitcnt vmcnt(0)" ::: "memory");
            const unsigned og = xb_add(&bar[XB_TOP], 1u);
            const unsigned tg = og / nx;
            if (og + 1u == (tg + 1u) * nx) xb_add(&bar[XB_TOPGEN], 1u);
            else XB_SPIN(xb_ld(&bar[XB_TOPGEN]) == tg, bar);
            __builtin_amdgcn_fence(__ATOMIC_ACQUIRE, "agent");
            xb_add(&bar[XB_XGEN(b.x)], 1u);
            asm volatile("s_waitcnt vmcnt(0)" ::: "memory");
        } else {
            XB_SPIN(xb_ld(&bar[XB_XGEN(b.x)]) == gen, bar);
            __builtin_amdgcn_fence(__ATOMIC_ACQUIRE, "agent");
            asm volatile("s_waitcnt vmcnt(0)" ::: "memory");
        }
    }
    __syncthreads();
}

typedef unsigned short bf16_t;
typedef float f32x4 __attribute__((ext_vector_type(4)));
typedef unsigned u32x4 __attribute__((ext_vector_type(4)));
typedef unsigned u32x2 __attribute__((ext_vector_type(2)));
#define LDSP PG8_LAS

constexpr int DM = 1024, DIN = 3840, DFF = 2816, MH = 32768;
constexpr int GLEN = 2 * 16384 + 64;
constexpr int LDS_BYTES = 150 * 1024;
constexpr size_t WS_WIN = 0, WS_WOUT = 15728640, WS_WGU = 19922944, WS_WD = 42991616, WS_MOD = 54525952, WS_LB = 55017472,
                 WS_RGC = 55025664  , WS_G = 61317120, WS_VT = 78127104, WS_YT = 94904320, WS_OF = 128458752, WS_OB = 162013184,
                 WS_H = 195567616, WS_U = 262676480, WS_END = 514334720;
constexpr float EPSN = 1e-6f;

struct P { const void* ptr[36]; };
#define PIN(i) ((const float*)p.ptr[(i) + z_])
#define PWS ((unsigned char*)p.ptr[35 + z_])
#define POUT ((float*)p.ptr[34 + z_])
#define OPQ_Z int z_ = 0; asm volatile("" : "+s"(z_));

__device__ __forceinline__ int opq_grid() { int g = gridDim.x; asm volatile("" : "+s"(g)); return g; }
__device__ __forceinline__ float bf2f(bf16_t v) { return __uint_as_float(((unsigned)v) << 16); }
__device__ __forceinline__ bf16_t f2bf(float f) { unsigned u = __float_as_uint(f); u += 0x7FFFu + ((u >> 16) & 1u); return (bf16_t)(u >> 16); }
__device__ __forceinline__ unsigned pk2_sw(float lo, float hi) { return (unsigned)f2bf(lo) | ((unsigned)f2bf(hi) << 16); }
__device__ __forceinline__ unsigned pk2(float lo, float hi) { unsigned r; asm volatile("v_cvt_pk_bf16_f32 %0, %1, %2" : "=v"(r) : "v"(lo), "v"(hi)); return r; }
__device__ __forceinline__ float lo16(unsigned w) { return __uint_as_float(w << 16); }
__device__ __forceinline__ float hi16(unsigned w) { return __uint_as_float(w & 0xffff0000u); }
__device__ __forceinline__ float sigm(float x) { return __builtin_amdgcn_rcpf(1.0f + __expf(-x)); }
__device__ __forceinline__ float wave_sum(float v) {
#pragma unroll
    for (int o = 32; o >= 1; o >>= 1) v += __shfl_xor(v, o);
    return v;
}

struct EpiRes {
    static constexpr bool PERM = false, AFTER_DRAIN = false;
    const float* base; float* out; const float* gate; int lshift;
    __device__ __forceinline__ void operator()(const f32x4 (&acc)[2][2][4][2], const pg8::Unit& u, int wr, int wc, int fr, int fq) const {
        const int row0 = u.pm * 256 + wr * 64 + fr, col0 = u.pn * 256 + wc * 32 + 4 * fq;
        const float* g = gate + (size_t)((u.pm * 256) >> lshift) * 6144 + col0;
        f32x4 gv[2][2];
#pragma unroll
        for (int bj = 0; bj < 2; ++bj)
#pragma unroll
            for (int n = 0; n < 2; ++n) gv[bj][n] = *(const f32x4*)(g + bj * 128 + n * 16);
#pragma unroll
        for (int ai = 0; ai < 2; ++ai)
#pragma unroll
            for (int mp = 0; mp < 2; ++mp) {
                f32x4 bs[2][2][2];
#pragma unroll
                for (int mm = 0; mm < 2; ++mm) { const size_t off = (size_t)(row0 + ai * 128 + (2 * mp + mm) * 16) * DM + col0;
#pragma unroll
                    for (int bj = 0; bj < 2; ++bj)
#pragma unroll
                        for (int n = 0; n < 2; ++n) bs[mm][bj][n] = *(const f32x4*)(base + off + bj * 128 + n * 16); }
#pragma unroll
                for (int mm = 0; mm < 2; ++mm) { const size_t off = (size_t)(row0 + ai * 128 + (2 * mp + mm) * 16) * DM + col0;
#pragma unroll
                    for (int bj = 0; bj < 2; ++bj)
#pragma unroll
                        for (int n = 0; n < 2; ++n) *(f32x4*)(out + off + bj * 128 + n * 16) = bs[mm][bj][n] + gv[bj][n] * acc[ai][bj][2 * mp + mm][n]; }
                asm volatile("" ::: "memory"); }
    }
};
struct EpiSwi {
    static constexpr bool PERM = true, AFTER_DRAIN = false;
    bf16_t* O;
    __device__ __forceinline__ void operator()(const f32x4 (&acc)[2][2][4][2], const pg8::Unit& u, int wr, int wc, int fr, int fq) const {
        const int row0 = u.pm * 256 + wr * 64 + fr, col0 = u.pn * 128 + wc * 32 + 8 * fq;
#pragma unroll
        for (int ai = 0; ai < 2; ++ai)
#pragma unroll
            for (int m = 0; m < 4; ++m) { bf16_t* rowp = O + (size_t)(row0 + ai * 128 + m * 16) * DFF + col0;
                float r[8];
#pragma unroll
                for (int n = 0; n < 2; ++n)
#pragma unroll
                    for (int j = 0; j < 4; ++j) { const float gt = acc[ai][0][m][n][j], up = acc[ai][1][m][n][j]; r[n * 4 + j] = gt * __builtin_amdgcn_rcpf(1.0f + __expf(-gt)) * up; }
                u32x4 w; w.x = pg8::cvt_pk_bf16(r[0], r[1]); w.y = pg8::cvt_pk_bf16(r[2], r[3]); w.z = pg8::cvt_pk_bf16(r[4], r[5]); w.w = pg8::cvt_pk_bf16(r[6], r[7]);
                *(u32x4*)rowp = w; }
    }
};
struct EpiB16 {
    static constexpr bool PERM = true, AFTER_DRAIN = false;
    bf16_t* O; int ldc;
    __device__ __forceinline__ void operator()(const f32x4 (&acc)[2][2][4][2], const pg8::Unit& u, int wr, int wc, int fr, int fq) const {
        const int row0 = u.pm * 256 + wr * 64 + fr, col0 = u.pn * 256 + wc * 32 + 8 * fq;
        float one = 1.0f; asm volatile("" : "+v"(one));
#pragma unroll
        for (int ai = 0; ai < 2; ++ai)
#pragma unroll
            for (int m = 0; m < 4; ++m) { bf16_t* rowp = O + (size_t)(row0 + ai * 128 + m * 16) * ldc + col0;
#pragma unroll
                for (int bj = 0; bj < 2; ++bj) { const f32x4 v0 = acc[ai][bj][m][0] * one, v1 = acc[ai][bj][m][1] * one;
                    u32x4 w; w.x = pg8::cvt_pk_bf16(v0[0], v0[1]); w.y = pg8::cvt_pk_bf16(v0[2], v0[3]); w.z = pg8::cvt_pk_bf16(v1[0], v1[1]); w.w = pg8::cvt_pk_bf16(v1[2], v1[3]);
                    *(u32x4*)(rowp + bj * 128) = w; } }
    }
};

__device__ __forceinline__ void tr_tile(const float* __restrict__ src, bf16_t* __restrict__ dst, int K, int N, int tk, int tn, int gu, float* sm) {
    int tid_ = threadIdx.x; asm volatile("" : "+v"(tid_)); OPQ_Z const int k0 = tk * 64, n0 = tn * 64, tid = tid_;
    for (int e = tid; e < 4096; e += 512) { const int r = e >> 6, c = e & 63; sm[r * 65 + c] = src[(size_t)(k0 + r) * N + n0 + c]; }
    __syncthreads();
    for (int e = tid; e < 4096; e += 512) { const int n = e >> 6, k = e & 63, nn = n0 + n;
        const int drow = gu == 0 ? nn : ((nn >> 7) * 256 + (gu == 2 ? 128 : 0) + (nn & 127));
        dst[(size_t)drow * K + k0 + k] = f2bf(sm[k * 65 + n]); }
    __syncthreads();
}
__device__ __forceinline__ void init_phase(const P& p, unsigned char* lds) {
    float* sm = (float*)lds;
    int tid_ = threadIdx.x; asm volatile("" : "+v"(tid_)); OPQ_Z const int tid = tid_, G = opq_grid(), bid = blockIdx.x;
    bf16_t* win = (bf16_t*)(PWS + WS_WIN); bf16_t* wout = (bf16_t*)(PWS + WS_WOUT); bf16_t* wgu = (bf16_t*)(PWS + WS_WGU); bf16_t* wd = (bf16_t*)(PWS + WS_WD);
    float* mod = (float*)(PWS + WS_MOD); float* lb = (float*)(PWS + WS_LB);
#pragma unroll 1
    for (int it = bid; it < 2 * 3328; it += G) {
        const int l = it / 3328, r = it % 3328;
        const float* src; bf16_t* dst; int K, N, gu = 0, tl;
        if (r < 960) { src = PIN(4) + (size_t)l * 1024 * 3840; dst = win + (size_t)l * 3840 * 1024; K = 1024; N = 3840; tl = r; }
        else if (r < 1216) { src = PIN(5) + (size_t)l * 1024 * 1024; dst = wout + (size_t)l * 1024 * 1024; K = 1024; N = 1024; tl = r - 960; }
        else if (r < 1920) { src = PIN(31) + (size_t)l * 1024 * 2816; dst = wgu + (size_t)l * 5632 * 1024; K = 1024; N = 2816; gu = 1; tl = r - 1216; }
        else if (r < 2624) { src = PIN(32) + (size_t)l * 1024 * 2816; dst = wgu + (size_t)l * 5632 * 1024; K = 1024; N = 2816; gu = 2; tl = r - 1920; }
        else { src = PIN(33) + (size_t)l * 2816 * 1024; dst = wd + (size_t)l * 1024 * 2816; K = 2816; N = 1024; tl = r - 2624; }
        const int ntn = N / 64;
        tr_tile(src, dst, K, N, tl / ntn, tl % ntn, gu, sm);
    }
    for (int e = tid; e < 10240; e += 512) { const int r = e >> 10, k = e & 1023; const float c = r < 8 ? PIN(2)[r * 1024 + k] : PIN(3)[(r - 8) * 1024 + k]; sm[e] = c * sigm(c); }
    __syncthreads();
    float* red = sm + 10240;
#pragma unroll 1
    for (int it = bid; it < 384; it += G) {
        const int l = it / 192, cgp = it % 192, cl = tid & 31, ks = tid >> 5;
        float acc[10];
#pragma unroll
        for (int r = 0; r < 10; ++r) acc[r] = 0.f;
        const float* w = PIN(7) + (size_t)l * 1024 * 6144 + cgp * 32 + cl;
        for (int i = 0; i < 64; ++i) { const int k = ks * 64 + i; const float wv = w[(size_t)k * 6144];
#pragma unroll
            for (int r = 0; r < 10; ++r) acc[r] += sm[r * 1024 + k] * wv; }
#pragma unroll
        for (int r = 0; r < 10; ++r) red[(ks * 10 + r) * 32 + cl] = acc[r];
        __syncthreads();
        if (tid < 320) { const int r = tid >> 5; float s = 0.f; for (int k2 = 0; k2 < 16; ++k2) s += red[(k2 * 10 + r) * 32 + cl];
            mod[(size_t)(l * 10 + r) * 6144 + cgp * 32 + cl] = s + PIN(8)[l * 6144 + cgp * 32 + cl]; }
        __syncthreads();
    }
    if (bid == G - 1) for (int e = tid; e < 1024; e += 512) { const int d = e >> 9, j = e & 511; const float x0 = PIN(23)[(d * 2 + 0) * 512 + j], x1 = PIN(23)[(d * 2 + 1) * 512 + j];
        const float m = fmaxf(x0, x1), e0 = __expf(x0 - m), e1 = __expf(x1 - m); lb[(d * 2 + 0) * 512 + j] = 0.f; lb[(d * 2 + 1) * 512 + j] = e1 / (e0 + e1); }
}

__device__ __forceinline__ void filter_gen(const P& p, unsigned char* lds, int l, int L) {
    float* zf = (float*)lds; float* ha = zf + 64 * 33; float* hb = ha + 64 * 65;
    int tid_ = threadIdx.x; asm volatile("" : "+v"(tid_)); OPQ_Z const int tid = tid_, G = opq_grid(), bid = blockIdx.x;
    bf16_t* Gf = (bf16_t*)(PWS + WS_G);
    const float* w1 = PIN(14) + l * 33 * 64; const float* b1 = PIN(15) + l * 64; const float* w2 = PIN(16) + l * 4096; const float* b2 = PIN(17) + l * 64;
    const float* w3 = PIN(18) + l * 4096; const float* b3 = PIN(19) + l * 64; const float* w4 = PIN(20) + l * 64 * 512; const float* fr_ = PIN(21) + l * 64;
    for (int e = bid * 512 + tid; e < 256 * 65; e += G * 512) { const int ch = e / 65, q = e % 65; const int idx = q < 33 ? q : 32 + 2 * L + (q - 33); Gf[(size_t)ch * GLEN + idx] = 0; }
    const int pos = tid & 63, jg = __builtin_amdgcn_readfirstlane(tid >> 6), lane = tid & 63, fr = lane & 15, fq = lane >> 4;
    const float d_lo = -4.605170186f / 1.5f, d_hi = -4.605170186f / 0.3f;
    bf16_t* h3b = (bf16_t*)(hb + 64 * 65);
    pg8::bf16x8 Bw[4][2];
#pragma unroll
    for (int nb = 0; nb < 4; ++nb)
#pragma unroll
        for (int ks = 0; ks < 2; ++ks)
#pragma unroll
            for (int e2 = 0; e2 < 8; ++e2) Bw[nb][ks][e2] = (short)f2bf(w4[(32 * ks + 8 * fq + e2) * 512 + 64 * jg + 16 * nb + fr]);
#pragma unroll 1
    for (int tile = bid; tile < L / 64; tile += G) {
        const int n0 = tile * 64;
        for (int e = tid; e < 64 * 33; e += 512) { const int ps = e / 33, i = e % 33; const float n = (float)(n0 + ps); float val;
            if (i == 0) val = n / (float)(L - 1);
            else { const int bnd = (i - 1) & 15; const float fb = 1e-4f + (float)bnd * ((15.0f - 1e-4f) / 15.0f); const float ang = (fb * n) * (6.283185307179586f / (float)L); val = (i <= 16) ? __cosf(ang) : -__sinf(ang); }
            zf[ps * 33 + i] = val; }
        __syncthreads();
        {
            float s[8];
#pragma unroll
            for (int jj = 0; jj < 8; ++jj) s[jj] = b1[jg * 8 + jj];
#pragma unroll 3
            for (int i = 0; i < 33; ++i) { const float hv = zf[pos * 33 + i]; const float* wr = w1 + i * 64 + jg * 8;
#pragma unroll
                for (int jj = 0; jj < 8; ++jj) s[jj] += hv * wr[jj]; }
#pragma unroll
            for (int jj = 0; jj < 8; ++jj) ha[pos * 65 + jg * 8 + jj] = __sinf(fr_[jg * 8 + jj] * s[jj]);
        }
        __syncthreads();
        {
            float s[8];
#pragma unroll
            for (int jj = 0; jj < 8; ++jj) s[jj] = b2[jg * 8 + jj];
#pragma unroll 4
            for (int i = 0; i < 64; ++i) { const float hv = ha[pos * 65 + i]; const float* wr = w2 + i * 64 + jg * 8;
#pragma unroll
                for (int jj = 0; jj < 8; ++jj) s[jj] += hv * wr[jj]; }
#pragma unroll
            for (int jj = 0; jj < 8; ++jj) hb[pos * 65 + jg * 8 + jj] = __sinf(fr_[jg * 8 + jj] * s[jj]);
        }
        __syncthreads();
        {
            float s[8];
#pragma unroll
            for (int jj = 0; jj < 8; ++jj) s[jj] = b3[jg * 8 + jj];
#pragma unroll 4
            for (int i = 0; i < 64; ++i) { const float hv = hb[pos * 65 + i]; const float* wr = w3 + i * 64 + jg * 8;
#pragma unroll
                for (int jj = 0; jj < 8; ++jj) s[jj] += hv * wr[jj]; }
#pragma unroll
            for (int jj = 0; jj < 8; ++jj) h3b[pos * 72 + jg * 8 + jj] = f2bf(__sinf(fr_[jg * 8 + jj] * s[jj]));
        }
        __syncthreads();
        f32x4 acc[4][4];
#pragma unroll
        for (int mb = 0; mb < 4; ++mb)
#pragma unroll
            for (int nb = 0; nb < 4; ++nb) acc[mb][nb] = (f32x4){0.f, 0.f, 0.f, 0.f};
        __builtin_amdgcn_s_setprio(1);
#pragma unroll
        for (int mb = 0; mb < 4; ++mb)
#pragma unroll
            for (int ks = 0; ks < 2; ++ks) { const pg8::bf16x8 av = *(const pg8::bf16x8*)(h3b + (16 * mb + fr) * 72 + 32 * ks + 8 * fq);
#pragma unroll
                for (int nb = 0; nb < 4; ++nb) acc[mb][nb] = __builtin_amdgcn_mfma_f32_16x16x32_bf16(av, Bw[nb][ks], acc[mb][nb], 0, 0, 0); }
        __builtin_amdgcn_s_setprio(0);
#pragma unroll
        for (int nb = 0; nb < 4; ++nb) { const int c2 = 64 * jg + 16 * nb + fr, ch = c2 & 255; const float delta = fabsf(d_lo + (float)ch * ((d_hi - d_lo) / 255.0f));
            bf16_t* grow = Gf + (size_t)ch * GLEN + 32 + L;
#pragma unroll
            for (int mb = 0; mb < 4; ++mb)
#pragma unroll
                for (int j = 0; j < 4; ++j) { const int n = n0 + 16 * mb + 4 * fq + j; const float tpos = (float)n / (float)(L - 1);
                    const float val = acc[mb][nb][j] * __expf(-tpos * delta);
                    if (c2 < 256) grow[-n] = f2bf(val); else if (n > 0) grow[n] = f2bf(val); } }
        __syncthreads();
    }
}

__device__ __forceinline__ void norm_mod(const float* x, const float* w, const float* modl, int sc_off, int sh_off, int rbase, int lshift, bf16_t* hb) {
    constexpr int NR = 4;
    int tid_ = threadIdx.x; asm volatile("" : "+v"(tid_)); OPQ_Z const int tid = tid_, lane = tid & 63, wid = tid >> 6, G = opq_grid();
#pragma unroll 1
    for (int row0 = (blockIdx.x * 8 + wid) * NR; row0 < MH; row0 += G * 8 * NR) {
        f32x4 v[NR][4]; float ss[NR];
#pragma unroll
        for (int rr = 0; rr < NR; ++rr) { const f32x4* xr = (const f32x4*)(x + (size_t)(row0 + rr) * DM);
#pragma unroll
            for (int i = 0; i < 4; ++i) v[rr][i] = xr[lane + 64 * i]; }
#pragma unroll
        for (int rr = 0; rr < NR; ++rr) { float s = 0.f;
#pragma unroll
            for (int i = 0; i < 4; ++i) s += v[rr][i][0] * v[rr][i][0] + v[rr][i][1] * v[rr][i][1] + v[rr][i][2] * v[rr][i][2] + v[rr][i][3] * v[rr][i][3];
            ss[rr] = wave_sum(s); }
        const float* mb = modl + (size_t)(rbase + (row0 >> lshift)) * 6144;
#pragma unroll
        for (int i = 0; i < 4; ++i) { const int col = (lane + 64 * i) * 4; const f32x4 wv = *(const f32x4*)(w + col), sc = *(const f32x4*)(mb + sc_off + col), sh = *(const f32x4*)(mb + sh_off + col);
            const f32x4 wm = wv * (1.0f + sc);
#pragma unroll
            for (int rr = 0; rr < NR; ++rr) { const float rstd = rsqrtf(ss[rr] * (1.0f / 1024.0f) + EPSN);
                const f32x4 h = v[rr][i] * rstd * wm + sh; u32x2 o; o.x = pk2(h[0], h[1]); o.y = pk2(h[2], h[3]); *(u32x2*)(hb + (size_t)(row0 + rr) * DM + col) = o; } }
    }
}
__device__ __forceinline__ void final_norm(float* x, const float* w) {
    constexpr int NR = 4;
    int tid_ = threadIdx.x; asm volatile("" : "+v"(tid_)); OPQ_Z const int tid = tid_, lane = tid & 63, wid = tid >> 6, G = opq_grid();
#pragma unroll 1
    for (int row0 = (blockIdx.x * 8 + wid) * NR; row0 < MH; row0 += G * 8 * NR) {
        f32x4 v[NR][4]; float ss[NR];
#pragma unroll
        for (int rr = 0; rr < NR; ++rr) { const f32x4* xr = (const f32x4*)(x + (size_t)(row0 + rr) * DM);
#pragma unroll
            for (int i = 0; i < 4; ++i) v[rr][i] = xr[lane + 64 * i]; }
#pragma unroll
        for (int rr = 0; rr < NR; ++rr) { float s = 0.f;
#pragma unroll
            for (int i = 0; i < 4; ++i) s += v[rr][i][0] * v[rr][i][0] + v[rr][i][1] * v[rr][i][1] + v[rr][i][2] * v[rr][i][2] + v[rr][i][3] * v[rr][i][3];
            ss[rr] = wave_sum(s); }
#pragma unroll
        for (int i = 0; i < 4; ++i) { const int col = (lane + 64 * i) * 4; const f32x4 wv = *(const f32x4*)(w + col);
#pragma unroll
            for (int rr = 0; rr < NR; ++rr) { const float rstd = rsqrtf(ss[rr] * (1.0f / 1024.0f) + EPSN); ((f32x4*)(x + (size_t)(row0 + rr) * DM))[lane + 64 * i] = v[rr][i] * rstd * wv; } }
    }
}
struct RgPrm { float ba[4], bx[4], sp[4]; };
#define RG_LOAD_W(p, l, tid, Bw, prm) do { const int w_ = (tid) >> 6, hd_ = w_ >> 1, dir_ = w_ & 1, fr_ = (tid) & 15, fq_ = ((tid) & 63) >> 4; \
        _Pragma("unroll") for (int nbk_ = 0; nbk_ < 8; ++nbk_) { const float* W_ = (nbk_ < 4 ? PIN(26) : PIN(28)) + (size_t)((((l) * 2 + dir_) * 4 + hd_) * 64) * 64 + 16 * (nbk_ & 3) + fr_; \
            _Pragma("unroll") for (int ks_ = 0; ks_ < 2; ++ks_) { _Pragma("unroll") for (int e_ = 0; e_ < 8; ++e_) Bw[nbk_][ks_][e_] = (short)f2bf(W_[(32 * ks_ + 8 * fq_ + e_) * 64]); } } \
        _Pragma("unroll") for (int nb_ = 0; nb_ < 4; ++nb_) { const int j_ = 64 * hd_ + 16 * nb_ + fr_; prm.ba[nb_] = PIN(27)[((l) * 2 + dir_) * 256 + j_]; prm.bx[nb_] = PIN(29)[((l) * 2 + dir_) * 256 + j_]; \
            prm.sp[nb_] = log1pf(__expf(-PIN(30)[((l) * 2 + dir_) * 256 + j_])); } } while (0)
template <bool PASS_C>
__device__ __forceinline__ void rg_tile(const P& p, unsigned char* lds, int l, int rowb, int L, int t0, const bf16_t* __restrict__ ub, bf16_t* __restrict__ yb, const pg8::bf16x8 (&Bw)[8][2], const RgPrm& prm, int tid) {
    OPQ_Z
    float* xr = (float*)lds; bf16_t* xrb = (bf16_t*)(lds + 32768); float* hs0 = (float*)(lds + 32768 + 16896); float* hs1 = hs0 + 32 * 256;
    const int lane = tid & 63, w = __builtin_amdgcn_readfirstlane(tid >> 6), hd = w >> 1, dir = w & 1, fr = lane & 15, fq = lane >> 4;
    const int tile = (rowb + t0) >> 5;
    float* CA = (float*)(PWS + WS_RGC); float* CB = CA + 524288; float* CIN = CB + 524288;
    {
        const float* cw = PIN(24) + l * 4 * 256; const float* cbp = PIN(25) + l * 256;
#pragma unroll
        for (int r = 0; r < 2; ++r) { const int item = tid + 512 * r, cg = item & 31, t = item >> 5, tok = t0 + t, c0 = cg * 8;
            const bf16_t* up = ub + (size_t)(rowb + tok) * DIN + 3328 + c0;
            u32x4 x[4];
            x[0] = tok - 2 >= 0 ? *(const u32x4*)(up - 2 * DIN) : (u32x4){0u, 0u, 0u, 0u};
            x[1] = tok - 1 >= 0 ? *(const u32x4*)(up - DIN) : (u32x4){0u, 0u, 0u, 0u};
            x[2] = *(const u32x4*)up;
            x[3] = tok + 1 < L ? *(const u32x4*)(up + DIN) : (u32x4){0u, 0u, 0u, 0u};
            float a[8];
            { const f32x4 b0 = *(const f32x4*)(cbp + c0), b1 = *(const f32x4*)(cbp + c0 + 4); a[0] = b0[0]; a[1] = b0[1]; a[2] = b0[2]; a[3] = b0[3]; a[4] = b1[0]; a[5] = b1[1]; a[6] = b1[2]; a[7] = b1[3]; }
#pragma unroll
            for (int k2 = 0; k2 < 4; ++k2) { const f32x4 w0 = *(const f32x4*)(cw + k2 * 256 + c0), w1 = *(const f32x4*)(cw + k2 * 256 + c0 + 4);
                a[0] += w0[0] * lo16(x[k2].x); a[1] += w0[1] * hi16(x[k2].x); a[2] += w0[2] * lo16(x[k2].y); a[3] += w0[3] * hi16(x[k2].y);
                a[4] += w1[0] * lo16(x[k2].z); a[5] += w1[1] * hi16(x[k2].z); a[6] += w1[2] * lo16(x[k2].w); a[7] += w1[3] * hi16(x[k2].w); }
            *(f32x4*)(xr + t * 256 + c0) = (f32x4){a[0], a[1], a[2], a[3]}; *(f32x4*)(xr + t * 256 + c0 + 4) = (f32x4){a[4], a[5], a[6], a[7]};
            *(u32x4*)(xrb + t * 264 + c0) = (u32x4){pk2(a[0], a[1]), pk2(a[2], a[3]), pk2(a[4], a[5]), pk2(a[6], a[7])}; }
    }
    __syncthreads();
    f32x4 acc[2][8];
#pragma unroll
    for (int tb = 0; tb < 2; ++tb)
#pragma unroll
        for (int nbk = 0; nbk < 8; ++nbk) acc[tb][nbk] = (f32x4){0.f, 0.f, 0.f, 0.f};
    __builtin_amdgcn_s_setprio(1);
#pragma unroll
    for (int tb = 0; tb < 2; ++tb)
#pragma unroll
        for (int ks = 0; ks < 2; ++ks) { const pg8::bf16x8 av = *(const pg8::bf16x8*)(xrb + (16 * tb + fr) * 264 + 64 * hd + 32 * ks + 8 * fq);
#pragma unroll
            for (int nbk = 0; nbk < 8; ++nbk) acc[tb][nbk] = __builtin_amdgcn_mfma_f32_16x16x32_bf16(av, Bw[nbk][ks], acc[tb][nbk], 0, 0, 0); }
    __builtin_amdgcn_s_setprio(0);
    float* hsd = dir ? hs1 : hs0;
#pragma unroll
    for (int nb = 0; nb < 4; ++nb) {
        const int j = 64 * hd + 16 * nb + fr;
        float PA[2][4], PB[2][4], TA[2], TB[2];
#pragma unroll
        for (int tb = 0; tb < 2; ++tb) { float ca = 1.f, cb = 0.f;
#pragma unroll
            for (int s2 = 0; s2 < 4; ++s2) { const int jj = dir ? 3 - s2 : s2; const int t = 16 * tb + 4 * fq + jj;
                const float r = __builtin_amdgcn_rcpf(1.0f + __expf(-(acc[tb][nb][jj] + prm.ba[nb]))), ig = __builtin_amdgcn_rcpf(1.0f + __expf(-(acc[tb][nb + 4][jj] + prm.bx[nb])));
                const float la = -8.0f * r * prm.sp[nb], a = __expf(la), bt = __builtin_amdgcn_sqrtf(fmaxf(1.0f - a * a, 0.f)) * ig * xr[t * 256 + j];
                cb = a * cb + bt; ca = a * ca; PA[tb][jj] = ca; PB[tb][jj] = cb; }
            TA[tb] = ca; TB[tb] = cb; }
        float EA[2], EB[2], GA[2], GB[2];
#pragma unroll
        for (int tb = 0; tb < 2; ++tb) { float ea = 1.f, eb = 0.f, ga = 1.f, gb = 0.f;
#pragma unroll
            for (int s2 = 0; s2 < 4; ++s2) { const int qq = dir ? 3 - s2 : s2; const float ta = __shfl(TA[tb], fr + 16 * qq), tb2 = __shfl(TB[tb], fr + 16 * qq);
                const bool prec = dir ? (qq > fq) : (qq < fq);
                if (prec) { eb = ta * eb + tb2; ea = ta * ea; }
                gb = ta * gb + tb2; ga = ta * ga; }
            EA[tb] = ea; EB[tb] = eb; GA[tb] = ga; GB[tb] = gb; }
        const int f1 = dir ? 1 : 0, f2 = dir ? 0 : 1;
        EB[f2] = EA[f2] * GB[f1] + EB[f2]; EA[f2] = EA[f2] * GA[f1];
        if (!PASS_C) { if (fq == 0) { CA[(size_t)(tile * 2 + dir) * 256 + j] = GA[f1] * GA[f2]; CB[(size_t)(tile * 2 + dir) * 256 + j] = GA[f2] * GB[f1] + GB[f2]; } }
        else { const float hin = CIN[(size_t)(tile * 2 + dir) * 256 + j];
#pragma unroll
            for (int tb = 0; tb < 2; ++tb)
#pragma unroll
                for (int jj = 0; jj < 4; ++jj) { const float af = PA[tb][jj] * EA[tb], bf = PA[tb][jj] * EB[tb] + PB[tb][jj]; hsd[(16 * tb + 4 * fq + jj) * 256 + j] = af * hin + bf; } }
    }
    __syncthreads();
    if (PASS_C) {
        const int wid = tid >> 6; const float* gain = PIN(6) + l * 1024 + 768 + lane * 4;
#pragma unroll 1
        for (int r = 0; r < 4; ++r) { const int t = wid + 8 * r; const size_t row = (size_t)(rowb + t0 + t);
            const f32x4 a = *(const f32x4*)(hs0 + t * 256 + lane * 4), b = *(const f32x4*)(hs1 + t * 256 + lane * 4);
            const u32x2 gw = *(const u32x2*)(ub + row * DIN + 3584 + lane * 4);
            const float gt[4] = {lo16(gw.x), hi16(gw.x), lo16(gw.y), hi16(gw.y)};
            float y[4], ss = 0.f;
#pragma unroll
            for (int e = 0; e < 4; ++e) { const float x = gt[e]; const float ge = x * (1.0f - __builtin_amdgcn_rcpf(1.0f + __expf(1.5957691216f * (x + 0.044715f * x * x * x)))); y[e] = (a[e] + b[e]) * ge; ss += y[e] * y[e]; }
            ss = wave_sum(ss);
            const float rstd = rsqrtf(ss * (1.0f / 256.0f) + EPSN);
            u32x2 o; o.x = pk2(y[0] * rstd * gain[0], y[1] * rstd * gain[1]); o.y = pk2(y[2] * rstd * gain[2], y[3] * rstd * gain[3]);
            *(u32x2*)(yb + row * DM + 768 + lane * 4) = o; }
        __syncthreads();
    }
}
__device__ __forceinline__ void rg_carry(const P& p, int B, int L) {
    int tid_ = threadIdx.x; asm volatile("" : "+v"(tid_)); OPQ_Z const int tid = tid_, lane = tid & 63, w = tid >> 6, G = opq_grid();
    const int ntl = L >> 5, per = ntl >> 6;
    const float* __restrict__ CA = (const float*)(PWS + WS_RGC); const float* __restrict__ CB = CA + 524288; float* __restrict__ CIN = (float*)(PWS + WS_RGC) + 2 * 524288;
#pragma unroll 1
    for (int ch = blockIdx.x * 8 + w; ch < B * 512; ch += G * 8) {
        const int b = ch >> 9, dir = (ch >> 8) & 1, j = ch & 255, tb = b * ntl;
        float a[8], bb[8], PA[8], PB[8]; float ca = 1.f, cb = 0.f;
#pragma unroll
        for (int i = 0; i < 8; ++i) if (i < per) { const int pidx = lane * per + i, k = dir ? ntl - 1 - pidx : pidx; const size_t idx = (size_t)((tb + k) * 2 + dir) * 256 + j; a[i] = CA[idx]; bb[i] = CB[idx]; }
#pragma unroll
        for (int i = 0; i < 8; ++i) if (i < per) { cb = a[i] * cb + bb[i]; ca = a[i] * ca; PA[i] = ca; PB[i] = cb; }
#pragma unroll
        for (int off = 1; off < 64; off <<= 1) { const float ta = __shfl_up(ca, off), tb2 = __shfl_up(cb, off); if (lane >= off) { cb = ca * tb2 + cb; ca = ca * ta; } }
        float eb = __shfl_up(cb, 1); if (lane == 0) eb = 0.f;
#pragma unroll
        for (int i = 0; i < 8; ++i) if (i < per) { const int pidx = lane * per + i, k = dir ? ntl - 1 - pidx : pidx; const size_t idx = (size_t)((tb + k) * 2 + dir) * 256 + j;
            CIN[idx] = (i == 0) ? eb : (PA[i - 1 < 0 ? 0 : i - 1] * eb + PB[i - 1 < 0 ? 0 : i - 1]); }
    }
}

constexpr size_t WS_HGU = 514334720, WS_HGD = 531111936, WS_BAR = 531243008, WS_NEED = 531243008 + 16384;
#define HG_BAR() do { asm volatile("s_waitcnt lgkmcnt(0)" ::: "memory"); __builtin_amdgcn_s_barrier(); asm volatile("" ::: "memory"); } while (0)
#ifdef HG32
#define HGSEG hg_seg
#else
#define HGSEG hg_seg64
#endif
template <bool FULL>
__device__ __forceinline__ void hg_seg(const P& p, unsigned char* lds, int l, int item, int L, int tid) {
    OPQ_Z
    const int lane = tid & 63, w = __builtin_amdgcn_readfirstlane(tid >> 6), fr = lane & 15, fq = lane >> 4, k = tid & 127, g = tid >> 7;
    const int nseg = L >> 10, chain = item / nseg, pseg = item - chain * nseg, b = chain >> 3, h = (chain >> 1) & 3, dir = chain & 1;
    const bf16_t* __restrict__ ub = (const bf16_t*)(PWS + WS_U); bf16_t* __restrict__ ob = (bf16_t*)(PWS + (dir ? WS_OB : WS_OF));
    float* __restrict__ Ug = (float*)(PWS + WS_HGU); float* __restrict__ Dg = (float*)(PWS + WS_HGD);
    bf16_t* QH = (bf16_t*)lds; bf16_t* QT = QH + 32 * 136; bf16_t* KT = QT + 32 * 136; bf16_t* KHT = KT + 48 * 136; bf16_t* VT = KHT + 128 * 40; bf16_t* ST = VT + 128 * 40; bf16_t* AM = ST + 128 * 136;
    float* GT = (float*)(AM + 32 * 40); float* DL = GT + 512;
    const float lbv = ((const float*)(PWS + WS_LB))[(dir * 2 + l) * 512 + h * 128 + k];
    const int zoff = (dir ? 2304 : 1792) + h * 128 + k, qoff = 768 + h * 128 + k, voff = 1280 + h * 128 + k;
    f32x4 S[8];
#pragma unroll
    for (int kb = 0; kb < 8; ++kb) S[kb] = (f32x4){0.f, 0.f, 0.f, 0.f};
    if (FULL) {
#pragma unroll 1
        for (int sp = 0; sp < pseg; ++sp) { const float* Up = Ug + (size_t)(chain * nseg + sp) * 16384 + 16 * w + fr; const float* Dp = Dg + (size_t)(chain * nseg + sp) * 128;
#pragma unroll
            for (int kb = 0; kb < 8; ++kb)
#pragma unroll
                for (int j = 0; j < 4; ++j) { const int kk = 16 * kb + 4 * fq + j; S[kb][j] = Dp[kk] * S[kb][j] + Up[(size_t)kk * 128]; } }
        for (int e = tid; e < 16 * 16; e += 512) AM[(e >> 4) * 40 + 16 + (e & 15)] = 0;
    }
    float dsum = 0.f;
    bf16_t rz[8], rv[8], rq[8];
    { const int n0 = pseg * 1024 + 8 * g;
#pragma unroll
      for (int i = 0; i < 8; ++i) { const int n = n0 + i, t = dir ? L - 1 - n : n; const bf16_t* up = ub + (size_t)(b * L + t) * DIN;
          rz[i] = up[zoff]; rv[i] = up[voff]; rq[i] = FULL ? up[qoff] : (bf16_t)0; } }
#pragma unroll 1
    for (int c = 0; c < 32; ++c) {
        float zz[8], qq[8], vv[8];
#pragma unroll
        for (int i = 0; i < 8; ++i) { zz[i] = bf2f(rz[i]); vv[i] = bf2f(rv[i]); if (FULL) qq[i] = bf2f(rq[i]); }
        if (c + 1 < 32) { const int n0 = pseg * 1024 + 32 * (c + 1) + 8 * g;
#pragma unroll
            for (int i = 0; i < 8; ++i) { const int n = n0 + i, t = dir ? L - 1 - n : n; const bf16_t* up = ub + (size_t)(b * L + t) * DIN;
                rz[i] = up[zoff]; rv[i] = up[voff]; if (FULL) rq[i] = up[qoff]; } }
        float bb[8], kk[8]; float run = 0.f;
#pragma unroll
        for (int i = 0; i < 8; ++i) { const float E = __builtin_amdgcn_exp2f(-1.44269504f * fmaxf(zz[i], -80.f)), rd = __builtin_amdgcn_rcpf(1.0f + E);
            run += __builtin_amdgcn_logf((1.0f + lbv * E) * rd); bb[i] = run; kk[i] = (1.0f - lbv) * E * rd; }
        GT[g * 128 + k] = run;
        if (FULL) {
#pragma unroll
            for (int kb = 0; kb < 8; ++kb) { u32x2 o; o.x = pk2_sw(S[kb][0], S[kb][1]); o.y = pk2_sw(S[kb][2], S[kb][3]); *(u32x2*)(ST + (16 * w + fr) * 136 + 16 * kb + 4 * fq) = o; }
        }
        HG_BAR();
        const float g0 = GT[k], g1 = GT[128 + k], g2 = GT[256 + k], g3 = GT[384 + k];
        const float r1 = g0 + g1, blast = r1 + g2 + g3;
        const float pre = g == 0 ? 0.f : (g == 1 ? g0 : (g == 2 ? r1 : r1 + g2));
        {
            unsigned kh[4], vt[4]; float khf[8];
#pragma unroll
            for (int i = 0; i < 8; ++i) { const float bv = pre + bb[i]; const int tau = 8 * g + i;
                khf[i] = kk[i] * __builtin_amdgcn_exp2f(blast - bv);
                if (FULL) {
                    const float qh = qq[i] * __builtin_amdgcn_exp2f(bv);
                    const float qt = g < 2 ? qh : qq[i] * __builtin_amdgcn_exp2f(bv - r1);
                    QH[tau * 136 + k] = (bf16_t)pg8::cvt_pk_bf16(qh, 0.f);
                    QT[tau * 136 + k] = (bf16_t)pg8::cvt_pk_bf16(qt, 0.f);
                    KT[(16 + tau) * 136 + k] = (bf16_t)pg8::cvt_pk_bf16(kk[i] * __builtin_amdgcn_exp2f(fminf(r1 - bv, 86.f)), 0.f);
                    if (g < 2) KT[tau * 136 + k] = (bf16_t)pg8::cvt_pk_bf16(kk[i] * __builtin_amdgcn_exp2f(fminf(-bv, 86.f)), 0.f);
                } }
#pragma unroll
            for (int i2 = 0; i2 < 4; ++i2) { kh[i2] = pg8::cvt_pk_bf16(khf[2 * i2], khf[2 * i2 + 1]); vt[i2] = pg8::cvt_pk_bf16(vv[2 * i2], vv[2 * i2 + 1]); }
            *(u32x4*)(KHT + k * 40 + 8 * g) = (u32x4){kh[0], kh[1], kh[2], kh[3]};
            *(u32x4*)(VT + k * 40 + 8 * g) = (u32x4){vt[0], vt[1], vt[2], vt[3]};
            if (g == 0) { DL[k] = __builtin_amdgcn_exp2f(blast); dsum += blast; }
        }
        HG_BAR();
        f32x4 o[2];
        if (FULL) {
            if (w < 3) {
                const int I = w == 0 ? 0 : 1, J = w == 2 ? 1 : 0;
                f32x4 a = (f32x4){0.f, 0.f, 0.f, 0.f};
#pragma unroll
                for (int ks = 0; ks < 4; ++ks) { const pg8::bf16x8 qa = *(const pg8::bf16x8*)(QT + (16 * I + fr) * 136 + 32 * ks + 8 * fq), kb2 = *(const pg8::bf16x8*)(KT + ((I ? 16 : 0) + 16 * J + fr) * 136 + 32 * ks + 8 * fq);
                    a = __builtin_amdgcn_mfma_f32_16x16x32_bf16(qa, kb2, a, 0, 0, 0); }
#pragma unroll
                for (int j = 0; j < 4; ++j) { const float val = (I != J || fr <= 4 * fq + j) ? a[j] : 0.f; AM[(16 * I + 4 * fq + j) * 40 + 16 * J + fr] = f2bf(val); }
            }
#pragma unroll
            for (int tb = 0; tb < 2; ++tb) { o[tb] = (f32x4){0.f, 0.f, 0.f, 0.f};
#pragma unroll
                for (int ks = 0; ks < 4; ++ks) { const pg8::bf16x8 qa = *(const pg8::bf16x8*)(QH + (16 * tb + fr) * 136 + 32 * ks + 8 * fq), sb = *(const pg8::bf16x8*)(ST + (16 * w + fr) * 136 + 32 * ks + 8 * fq);
                    o[tb] = __builtin_amdgcn_mfma_f32_16x16x32_bf16(qa, sb, o[tb], 0, 0, 0); } }
            HG_BAR();
        }
        const pg8::bf16x8 vb = *(const pg8::bf16x8*)(VT + (16 * w + fr) * 40 + 8 * fq);
        if (FULL) {
#pragma unroll
            for (int tb = 0; tb < 2; ++tb) { const pg8::bf16x8 aa = *(const pg8::bf16x8*)(AM + (16 * tb + fr) * 40 + 8 * fq);
                o[tb] = __builtin_amdgcn_mfma_f32_16x16x32_bf16(aa, vb, o[tb], 0, 0, 0);
#pragma unroll
                for (int j = 0; j < 4; ++j) { const int n = pseg * 1024 + 32 * c + 16 * tb + 4 * fq + j, t = dir ? L - 1 - n : n; ob[(size_t)(b * L + t) * 512 + h * 128 + 16 * w + fr] = f2bf(o[tb][j]); } }
        }
#pragma unroll
        for (int kb = 0; kb < 8; ++kb) { const pg8::bf16x8 ka = *(const pg8::bf16x8*)(KHT + (16 * kb + fr) * 40 + 8 * fq); const f32x4 dl = *(const f32x4*)(DL + 16 * kb + 4 * fq);
            S[kb] = __builtin_amdgcn_mfma_f32_16x16x32_bf16(ka, vb, S[kb] * dl, 0, 0, 0); }
    }
    if (!FULL) {
        float* Up = Ug + (size_t)item * 16384 + 16 * w + fr;
#pragma unroll
        for (int kb = 0; kb < 8; ++kb)
#pragma unroll
            for (int j = 0; j < 4; ++j) Up[(size_t)(16 * kb + 4 * fq + j) * 128] = S[kb][j];
        if (g == 0) Dg[(size_t)item * 128 + k] = __builtin_amdgcn_exp2f(dsum);
    }
    __syncthreads();
}


template <bool FULL>
__device__ __forceinline__ void hg_seg64(const P& p, unsigned char* lds, int l, int item, int L, int tid) {
    OPQ_Z
    const int lane = tid & 63, w = __builtin_amdgcn_readfirstlane(tid >> 6), fr = lane & 15, fq = lane >> 4, k = tid & 127, g = tid >> 7;
    const int nseg = L >> 10, chain = item / nseg, pseg = item - chain * nseg, b = chain >> 3, h = (chain >> 1) & 3, dir = chain & 1;
    const bf16_t* __restrict__ ub = (const bf16_t*)(PWS + WS_U); bf16_t* __restrict__ ob = (bf16_t*)(PWS + (dir ? WS_OB : WS_OF));
    float* __restrict__ Ug = (float*)(PWS + WS_HGU); float* __restrict__ Dg = (float*)(PWS + WS_HGD);
    bf16_t* QH = (bf16_t*)lds; bf16_t* QT = QH + 64 * 136; bf16_t* KT = QT + 32 * 136; bf16_t* KHT = KT + 96 * 136; bf16_t* VT = KHT + 128 * 72; bf16_t* ST = VT + 128 * 72; bf16_t* AM = ST + 128 * 136;
    float* GT = (float*)(AM + 64 * 72); float* DL = GT + 512;
    const float lbv = ((const float*)(PWS + WS_LB))[(dir * 2 + l) * 512 + h * 128 + k];
    const int zoff = (dir ? 2304 : 1792) + h * 128 + k, qoff = 768 + h * 128 + k, voff = 1280 + h * 128 + k;
    f32x4 S[8];
#pragma unroll
    for (int kb = 0; kb < 8; ++kb) S[kb] = (f32x4){0.f, 0.f, 0.f, 0.f};
    if (FULL) {
        if (pseg > 0) {
            f32x4 Pd[8];
            { const float* Up = Ug + (size_t)(chain * nseg + pseg - 1) * 16384 + 16 * w + fr; const float* Dp = Dg + (size_t)(chain * nseg + pseg - 1) * 128;
#pragma unroll
              for (int kb = 0; kb < 8; ++kb)
#pragma unroll
                  for (int j = 0; j < 4; ++j) { const int kk = 16 * kb + 4 * fq + j; S[kb][j] = Up[(size_t)kk * 128]; Pd[kb][j] = Dp[kk]; } }
#pragma unroll 1
            for (int sp = pseg - 2; sp >= 0; --sp) {
                bool nz = false;
#pragma unroll
                for (int kb = 0; kb < 8; ++kb) nz = nz || (Pd[kb][0] != 0.f) || (Pd[kb][1] != 0.f) || (Pd[kb][2] != 0.f) || (Pd[kb][3] != 0.f);
                if (!__any(nz)) break;
                const float* Up = Ug + (size_t)(chain * nseg + sp) * 16384 + 16 * w + fr; const float* Dp = Dg + (size_t)(chain * nseg + sp) * 128;
#pragma unroll
                for (int kb = 0; kb < 8; ++kb)
#pragma unroll
                    for (int j = 0; j < 4; ++j) { const int kk = 16 * kb + 4 * fq + j; S[kb][j] += Pd[kb][j] * Up[(size_t)kk * 128]; Pd[kb][j] *= Dp[kk]; } }
        }
        for (int e = tid; e < 64 * 72 / 8; e += 512) *(u32x4*)(AM + e * 8) = (u32x4){0u, 0u, 0u, 0u};
    }
    float dsum = 0.f;
    bf16_t rz[16], rv[16], rq[16];
    { const int n0 = pseg * 1024 + 16 * g;
#pragma unroll
      for (int i = 0; i < 16; ++i) { const int n = n0 + i, t = dir ? L - 1 - n : n; const bf16_t* up = ub + (size_t)(b * L + t) * DIN;
          rz[i] = up[zoff]; rv[i] = up[voff]; rq[i] = FULL ? up[qoff] : (bf16_t)0; } }
#pragma unroll 1
    for (int c = 0; c < 16; ++c) {
        float qq[16], vv[16], bb[16], kk[16]; float run = 0.f;
#pragma unroll
        for (int i = 0; i < 16; ++i) { const float zz = bf2f(rz[i]); vv[i] = bf2f(rv[i]); qq[i] = FULL ? bf2f(rq[i]) : 0.f;
            const float E = __builtin_amdgcn_exp2f(-1.44269504f * fmaxf(zz, -80.f)), rd = __builtin_amdgcn_rcpf(1.0f + E);
            run += __builtin_amdgcn_logf((1.0f + lbv * E) * rd); bb[i] = run; kk[i] = (1.0f - lbv) * E * rd; }
        GT[g * 128 + k] = run;
        if (FULL) {
#pragma unroll
            for (int kb = 0; kb < 8; ++kb) { u32x2 o; o.x = pk2_sw(S[kb][0], S[kb][1]); o.y = pk2_sw(S[kb][2], S[kb][3]); *(u32x2*)(ST + (16 * w + fr) * 136 + 16 * kb + 4 * fq) = o; }
        }
        HG_BAR();
        const float g0 = GT[k], g1 = GT[128 + k], g2 = GT[256 + k], g3 = GT[384 + k];
        const float r1 = g0 + g1, blast = r1 + g2 + g3;
        const float pre = g == 0 ? 0.f : (g == 1 ? g0 : (g == 2 ? r1 : r1 + g2));
        {
            float khf[16];
#pragma unroll
            for (int i = 0; i < 16; ++i) { const float bv = pre + bb[i]; const int tau = 16 * g + i;
                khf[i] = kk[i] * __builtin_amdgcn_exp2f(blast - bv);
                if (FULL) {
                    QH[tau * 136 + k] = (bf16_t)pg8::cvt_pk_bf16(qq[i] * __builtin_amdgcn_exp2f(bv), 0.f);
                    if (g >= 2) QT[(tau - 32) * 136 + k] = (bf16_t)pg8::cvt_pk_bf16(qq[i] * __builtin_amdgcn_exp2f(bv - r1), 0.f);
                    KT[(32 + tau) * 136 + k] = (bf16_t)pg8::cvt_pk_bf16(kk[i] * __builtin_amdgcn_exp2f(fminf(r1 - bv, 86.f)), 0.f);
                    if (g < 2) KT[tau * 136 + k] = (bf16_t)pg8::cvt_pk_bf16(kk[i] * __builtin_amdgcn_exp2f(fminf(-bv, 86.f)), 0.f);
                } }
            unsigned kh[8], vt[8];
#pragma unroll
            for (int i2 = 0; i2 < 8; ++i2) { kh[i2] = pg8::cvt_pk_bf16(khf[2 * i2], khf[2 * i2 + 1]); vt[i2] = pg8::cvt_pk_bf16(vv[2 * i2], vv[2 * i2 + 1]); }
            *(u32x4*)(KHT + k * 72 + 16 * g) = (u32x4){kh[0], kh[1], kh[2], kh[3]}; *(u32x4*)(KHT + k * 72 + 16 * g + 8) = (u32x4){kh[4], kh[5], kh[6], kh[7]};
            *(u32x4*)(VT + k * 72 + 16 * g) = (u32x4){vt[0], vt[1], vt[2], vt[3]}; *(u32x4*)(VT + k * 72 + 16 * g + 8) = (u32x4){vt[4], vt[5], vt[6], vt[7]};
            if (g == 0) { DL[k] = __builtin_amdgcn_exp2f(blast); dsum += blast; }
        }
        HG_BAR();
        if (c + 1 < 16) { const int n0 = pseg * 1024 + 64 * (c + 1) + 16 * g;
#pragma unroll
            for (int i = 0; i < 16; ++i) { const int n = n0 + i, t = dir ? L - 1 - n : n; const bf16_t* up = ub + (size_t)(b * L + t) * DIN;
                rz[i] = up[zoff]; rv[i] = up[voff]; if (FULL) rq[i] = up[qoff]; } }
        f32x4 o[4];
        if (FULL) {
#pragma unroll 1
            for (int idx = w; idx < 10; idx += 8) {
                const int a = idx < 1 ? 0 : (idx < 3 ? 1 : (idx < 6 ? 2 : 3)), cc = idx - a * (a + 1) / 2;
                const bf16_t* qrow = (a < 2) ? (QH + (16 * a + fr) * 136) : (QT + (16 * a - 32 + fr) * 136);
                const bf16_t* krow = KT + ((a < 2 ? 0 : 32) + 16 * cc + fr) * 136;
                f32x4 av = (f32x4){0.f, 0.f, 0.f, 0.f};
#pragma unroll
                for (int ks = 0; ks < 4; ++ks) av = __builtin_amdgcn_mfma_f32_16x16x32_bf16(*(const pg8::bf16x8*)(qrow + 32 * ks + 8 * fq), *(const pg8::bf16x8*)(krow + 32 * ks + 8 * fq), av, 0, 0, 0);
#pragma unroll
                for (int j = 0; j < 4; ++j) { const float val = (a != cc || fr <= 4 * fq + j) ? av[j] : 0.f; AM[(16 * a + 4 * fq + j) * 72 + 16 * cc + fr] = f2bf(val); }
            }
#pragma unroll
            for (int tb = 0; tb < 4; ++tb) { o[tb] = (f32x4){0.f, 0.f, 0.f, 0.f};
#pragma unroll
                for (int ks = 0; ks < 4; ++ks) o[tb] = __builtin_amdgcn_mfma_f32_16x16x32_bf16(*(const pg8::bf16x8*)(QH + (16 * tb + fr) * 136 + 32 * ks + 8 * fq), *(const pg8::bf16x8*)(ST + (16 * w + fr) * 136 + 32 * ks + 8 * fq), o[tb], 0, 0, 0); }
            HG_BAR();
        }
        const pg8::bf16x8 vb0 = *(const pg8::bf16x8*)(VT + (16 * w + fr) * 72 + 8 * fq), vb1 = *(const pg8::bf16x8*)(VT + (16 * w + fr) * 72 + 32 + 8 * fq);
        if (FULL) {
#pragma unroll
            for (int tb = 0; tb < 4; ++tb) {
                o[tb] = __builtin_amdgcn_mfma_f32_16x16x32_bf16(*(const pg8::bf16x8*)(AM + (16 * tb + fr) * 72 + 8 * fq), vb0, o[tb], 0, 0, 0);
                if (tb >= 2) o[tb] = __builtin_amdgcn_mfma_f32_16x16x32_bf16(*(const pg8::bf16x8*)(AM + (16 * tb + fr) * 72 + 32 + 8 * fq), vb1, o[tb], 0, 0, 0);
#pragma unroll
                for (int j = 0; j < 4; ++j) { const int n = pseg * 1024 + 64 * c + 16 * tb + 4 * fq + j, t = dir ? L - 1 - n : n; ob[(size_t)(b * L + t) * 512 + h * 128 + 16 * w + fr] = f2bf(o[tb][j]); } }
        }
#pragma unroll
        for (int kb = 0; kb < 8; ++kb) { const f32x4 dl = *(const f32x4*)(DL + 16 * kb + 4 * fq);
            S[kb] = __builtin_amdgcn_mfma_f32_16x16x32_bf16(*(const pg8::bf16x8*)(KHT + (16 * kb + fr) * 72 + 8 * fq), vb0, S[kb] * dl, 0, 0, 0);
            S[kb] = __builtin_amdgcn_mfma_f32_16x16x32_bf16(*(const pg8::bf16x8*)(KHT + (16 * kb + fr) * 72 + 32 + 8 * fq), vb1, S[kb], 0, 0, 0); }
    }
    if (!FULL) {
        float* Up = Ug + (size_t)item * 16384 + 16 * w + fr;
#pragma unroll
        for (int kb = 0; kb < 8; ++kb)
#pragma unroll
            for (int j = 0; j < 4; ++j) Up[(size_t)(16 * kb + 4 * fq + j) * 128] = S[kb][j];
        if (g == 0) Dg[(size_t)item * 128 + k] = __builtin_amdgcn_exp2f(dsum);
    }
    __syncthreads();
}


__device__ __forceinline__ void hg_passA64(const P& p, unsigned char* lds, int l, int item, int L, int tid) {
    OPQ_Z
    const int lane = tid & 63, w = __builtin_amdgcn_readfirstlane(tid >> 6), fr = lane & 15, fq = lane >> 4, k = tid & 127, g = tid >> 7;
    const int nseg = L >> 10, chain = item / nseg, pseg = item - chain * nseg, b = chain >> 3, h = (chain >> 1) & 3, dir = chain & 1;
    const bf16_t* __restrict__ ub = (const bf16_t*)(PWS + WS_U);
    float* __restrict__ Ug = (float*)(PWS + WS_HGU); float* __restrict__ Dg = (float*)(PWS + WS_HGD);
    bf16_t* KHT = (bf16_t*)lds; bf16_t* VT = KHT + 128 * 72; float* GT = (float*)(VT + 128 * 72); unsigned* NZ = (unsigned*)(GT + 512);
    const float lbv = ((const float*)(PWS + WS_LB))[(dir * 2 + l) * 512 + h * 128 + k];
    const int zoff = (dir ? 2304 : 1792) + h * 128 + k, voff = 1280 + h * 128 + k;
    f32x4 S[8];
#pragma unroll
    for (int kb = 0; kb < 8; ++kb) S[kb] = (f32x4){0.f, 0.f, 0.f, 0.f};
    float Pk = 1.0f;
    bf16_t rz[16], rv[16];
    { const int n0 = pseg * 1024 + 64 * 15 + 16 * g;
#pragma unroll
      for (int i = 0; i < 16; ++i) { const int n = n0 + i, t = dir ? L - 1 - n : n; const bf16_t* up = ub + (size_t)(b * L + t) * DIN; rz[i] = up[zoff]; rv[i] = up[voff]; } }
#pragma unroll 1
    for (int c = 15; c >= 0; --c) {
        float vv[16], bb[16], kk[16]; float run = 0.f;
#pragma unroll
        for (int i = 0; i < 16; ++i) { const float zz = bf2f(rz[i]); vv[i] = bf2f(rv[i]);
            const float E = __builtin_amdgcn_exp2f(-1.44269504f * fmaxf(zz, -80.f)), rd = __builtin_amdgcn_rcpf(1.0f + E);
            run += __builtin_amdgcn_logf((1.0f + lbv * E) * rd); bb[i] = run; kk[i] = (1.0f - lbv) * E * rd; }
        if (c > 0) { const int n0 = pseg * 1024 + 64 * (c - 1) + 16 * g;
#pragma unroll
            for (int i = 0; i < 16; ++i) { const int n = n0 + i, t = dir ? L - 1 - n : n; const bf16_t* up = ub + (size_t)(b * L + t) * DIN; rz[i] = up[zoff]; rv[i] = up[voff]; } }
        GT[g * 128 + k] = run;
        HG_BAR();
        const float g0 = GT[k], g1 = GT[128 + k], g2 = GT[256 + k], g3 = GT[384 + k];
        const float r1 = g0 + g1, blast = r1 + g2 + g3;
        const float pre = g == 0 ? 0.f : (g == 1 ? g0 : (g == 2 ? r1 : r1 + g2));
        {
            unsigned kh[8], vt[8];
#pragma unroll
            for (int i2 = 0; i2 < 8; ++i2) { const float k0 = kk[2 * i2] * __builtin_amdgcn_exp2f(blast - (pre + bb[2 * i2])) * Pk, k1 = kk[2 * i2 + 1] * __builtin_amdgcn_exp2f(blast - (pre + bb[2 * i2 + 1])) * Pk;
                kh[i2] = pg8::cvt_pk_bf16(k0, k1); vt[i2] = pg8::cvt_pk_bf16(vv[2 * i2], vv[2 * i2 + 1]); }
            *(u32x4*)(KHT + k * 72 + 16 * g) = (u32x4){kh[0], kh[1], kh[2], kh[3]}; *(u32x4*)(KHT + k * 72 + 16 * g + 8) = (u32x4){kh[4], kh[5], kh[6], kh[7]};
            *(u32x4*)(VT + k * 72 + 16 * g) = (u32x4){vt[0], vt[1], vt[2], vt[3]}; *(u32x4*)(VT + k * 72 + 16 * g + 8) = (u32x4){vt[4], vt[5], vt[6], vt[7]};
        }
        Pk *= __builtin_amdgcn_exp2f(blast);
        { const bool anynz = __any(Pk != 0.f); if (lane == 0) NZ[w] = anynz ? 1u : 0u; }
        HG_BAR();
        const pg8::bf16x8 vb0 = *(const pg8::bf16x8*)(VT + (16 * w + fr) * 72 + 8 * fq), vb1 = *(const pg8::bf16x8*)(VT + (16 * w + fr) * 72 + 32 + 8 * fq);
        const unsigned nzall = NZ[0] | NZ[1] | NZ[2] | NZ[3] | NZ[4] | NZ[5] | NZ[6] | NZ[7];
#pragma unroll
        for (int kb = 0; kb < 8; ++kb) {
            S[kb] = __builtin_amdgcn_mfma_f32_16x16x32_bf16(*(const pg8::bf16x8*)(KHT + (16 * kb + fr) * 72 + 8 * fq), vb0, S[kb], 0, 0, 0);
            S[kb] = __builtin_amdgcn_mfma_f32_16x16x32_bf16(*(const pg8::bf16x8*)(KHT + (16 * kb + fr) * 72 + 32 + 8 * fq), vb1, S[kb], 0, 0, 0); }
        if (nzall == 0u) break;
    }
    {
        float* Up = Ug + (size_t)item * 16384 + 16 * w + fr;
#pragma unroll
        for (int kb = 0; kb < 8; ++kb)
#pragma unroll
            for (int j = 0; j < 4; ++j) Up[(size_t)(16 * kb + 4 * fq + j) * 128] = S[kb][j];
        if (g == 0) Dg[(size_t)item * 128 + k] = Pk;
    }
    __syncthreads();
}

__device__ __forceinline__ void prep_phase(const P& p, unsigned char* lds, int l, int B, int L) {
    int tid_ = threadIdx.x; asm volatile("" : "+v"(tid_)); OPQ_Z const int tid = tid_, G = opq_grid();
    pg8::bf16x8 Bw[8][2]; RgPrm prm; RG_LOAD_W(p, l, tid, Bw, prm);
    const bf16_t* __restrict__ ub = (const bf16_t*)(PWS + WS_U); bf16_t* __restrict__ vT = (bf16_t*)(PWS + WS_VT);
    bf16_t* sm = (bf16_t*)lds;
    const float* cw = PIN(12) + l * 3 * 768; const float* cb = PIN(13) + l * 768;
#pragma unroll 1
    for (int tile = blockIdx.x; tile < MH / 64; tile += G) {
        const int r0 = tile * 64, rowb = (r0 / L) * L, t0 = r0 - rowb;
#pragma unroll 4
        for (int r = 0; r < 4; ++r) { const int item = tid + 512 * r, cg = item & 31, t = item >> 5, tok = t0 + t, c0 = cg * 8;
            const bf16_t* up = ub + (size_t)(r0 + t) * DIN + c0;
            float x1[8], vv[8];
            { const f32x4 b0 = *(const f32x4*)(cb + 256 + c0), b1 = *(const f32x4*)(cb + 256 + c0 + 4), d0 = *(const f32x4*)(cb + 512 + c0), d1 = *(const f32x4*)(cb + 512 + c0 + 4);
#pragma unroll
              for (int e = 0; e < 4; ++e) { x1[e] = b0[e]; x1[4 + e] = b1[e]; vv[e] = d0[e]; vv[4 + e] = d1[e]; } }
#pragma unroll
            for (int k2 = 0; k2 < 3; ++k2) { const int tt = tok + k2 - 1;
                if (tt >= 0 && tt < L) { const u32x4 xa = *(const u32x4*)(up + (k2 - 1) * DIN + 256), xb = *(const u32x4*)(up + (k2 - 1) * DIN + 512);
                    const float* wa = cw + k2 * 768 + 256 + c0; const float* wb = cw + k2 * 768 + 512 + c0;
                    const f32x4 a0 = *(const f32x4*)wa, a1 = *(const f32x4*)(wa + 4), e0 = *(const f32x4*)wb, e1 = *(const f32x4*)(wb + 4);
                    x1[0] += a0[0] * lo16(xa.x); x1[1] += a0[1] * hi16(xa.x); x1[2] += a0[2] * lo16(xa.y); x1[3] += a0[3] * hi16(xa.y);
                    x1[4] += a1[0] * lo16(xa.z); x1[5] += a1[1] * hi16(xa.z); x1[6] += a1[2] * lo16(xa.w); x1[7] += a1[3] * hi16(xa.w);
                    vv[0] += e0[0] * lo16(xb.x); vv[1] += e0[1] * hi16(xb.x); vv[2] += e0[2] * lo16(xb.y); vv[3] += e0[3] * hi16(xb.y);
                    vv[4] += e1[0] * lo16(xb.z); vv[5] += e1[1] * hi16(xb.z); vv[6] += e1[2] * lo16(xb.w); vv[7] += e1[3] * hi16(xb.w); } }
#pragma unroll
            for (int e = 0; e < 8; ++e) sm[(c0 + e) * 72 + t] = f2bf(vv[e] * x1[e]); }
        __syncthreads();
        for (int e = tid; e < 256 * 8; e += 512) { const int c = e >> 3, t8 = e & 7; *(u32x4*)(vT + (size_t)c * MH + r0 + 8 * t8) = *(const u32x4*)(sm + c * 72 + 8 * t8); }
        __syncthreads();
#pragma unroll 1
        for (int sub = 0; sub < 2; ++sub) rg_tile<false>(p, lds, l, rowb, L, t0 + 32 * sub, ub, nullptr, Bw, prm, tid);
    }
#ifndef HG_NAIVE
    { int t2_ = threadIdx.x; asm volatile("" : "+v"(t2_));
#pragma unroll 1
      for (int it = blockIdx.x; it < 256; it += G) hg_passA64(p, lds, l, it, L, t2_);
#ifdef DUP_HG
      for (int it = blockIdx.x; it < 256; it += G) HGSEG<false>(p, lds, l, it, L, t2_);
#endif
    }
#endif
}

__device__ __forceinline__ void hy_conv_naive(const P& p, unsigned char* lds, int B, int L) {
    int tid_ = threadIdx.x; asm volatile("" : "+v"(tid_)); OPQ_Z const int tid = tid_, G = opq_grid();
    const bf16_t* __restrict__ vT = (const bf16_t*)(PWS + WS_VT); const bf16_t* __restrict__ Gf = (const bf16_t*)(PWS + WS_G); float* __restrict__ yT = (float*)(PWS + WS_YT);
    bf16_t* vs = (bf16_t*)lds; bf16_t* gs = vs + 16384;
#pragma unroll 1
    for (int it = blockIdx.x; it < 256 * B; it += G) { const int c = it / B, b = it % B;
        for (int e = tid; e < L; e += 512) vs[e] = vT[(size_t)c * MH + b * L + e];
        for (int e = tid; e < 2 * L + 64; e += 512) gs[e] = Gf[(size_t)c * GLEN + e];
        __syncthreads();
#pragma unroll 1
        for (int t = tid; t < L; t += 512) { float acc = 0.f; const bf16_t* gp = gs + 32 + L - t;
            for (int s = 0; s < L; ++s) acc += bf2f(gp[s]) * bf2f(vs[s]);
            yT[(size_t)c * MH + b * L + t] = acc; }
        __syncthreads();
    }
}


__device__ __forceinline__ void hy_conv_mfma(const P& p, unsigned char* lds, int B, int L) {
    int tid_ = threadIdx.x; asm volatile("" : "+v"(tid_)); OPQ_Z const int tid = tid_, G = opq_grid(), lane = tid & 63, wid = __builtin_amdgcn_readfirstlane(tid >> 6), fr = lane & 15, fq = lane >> 4;
    const bf16_t* __restrict__ vT = (const bf16_t*)(PWS + WS_VT); const bf16_t* __restrict__ Gf = (const bf16_t*)(PWS + WS_G); float* __restrict__ yT = (float*)(PWS + WS_YT);
    bf16_t* vbuf = (bf16_t*)lds; bf16_t* zbuf = vbuf + MH; bf16_t* gbuf = zbuf + 32;
    const int lgB = (B == 8) ? 3 : 1, cbw = 2048 >> lgB;
#pragma unroll 1
    for (int c = blockIdx.x; c < 256; c += G) {
        for (int e = tid; e < MH / 8; e += 512) *(u32x4*)(vbuf + e * 8) = *(const u32x4*)(vT + (size_t)c * MH + e * 8);
        if (tid < 4) *(u32x4*)(zbuf + tid * 8) = (u32x4){0u, 0u, 0u, 0u};
        for (int e = tid; e < (2 * L + 64) / 8; e += 512) *(u32x4*)(gbuf + e * 8) = *(const u32x4*)(Gf + (size_t)c * GLEN + e * 8);
        __syncthreads();
        const int T0 = 2 * wid * cbw, bq = fr & (B - 1), sgm = fr >> lgB;
        const int tc0 = T0 + 128 * sgm, tc1 = tc0 + cbw;
        f32x4 acc[8][2];
#pragma unroll
        for (int r = 0; r < 8; ++r) { acc[r][0] = (f32x4){0.f, 0.f, 0.f, 0.f}; acc[r][1] = (f32x4){0.f, 0.f, 0.f, 0.f}; }
        const bf16_t* ga = gbuf + 32 + L - 8 * fr + 8 * fq - 8;
        const bf16_t* vrow = vbuf + bq * L + 8 * fq;
        const unsigned lim = (unsigned)(L - 32);
        const int Dlo = T0 - L + 32, Dhi = T0 + 2 * cbw - 128;
#define HY_LOAD(SET, Dv) do { const int D_ = (Dv); \
            WL[SET] = *(const u32x4*)(ga - D_); WH[SET] = *(const u32x4*)(ga - D_ + 8); \
            { const int s0_ = tc0 - D_, s1_ = tc1 - D_; \
              BV[SET][0] = *(const pg8::bf16x8*)(((unsigned)s0_ <= lim) ? (vrow + s0_) : (zbuf + 8 * fq)); \
              BV[SET][1] = *(const pg8::bf16x8*)(((unsigned)s1_ <= lim) ? (vrow + s1_) : (zbuf + 8 * fq)); } } while (0)
#define HY_MMA(SET) do { const unsigned w0_ = WL[SET].x, w1_ = WL[SET].y, w2_ = WL[SET].z, w3_ = WL[SET].w, w4_ = WH[SET].x, w5_ = WH[SET].y, w6_ = WH[SET].z, w7_ = WH[SET].w; \
            const unsigned x0_ = __builtin_amdgcn_alignbit(w1_, w0_, 16), x1_ = __builtin_amdgcn_alignbit(w2_, w1_, 16), x2_ = __builtin_amdgcn_alignbit(w3_, w2_, 16), x3_ = __builtin_amdgcn_alignbit(w4_, w3_, 16), \
                           x4_ = __builtin_amdgcn_alignbit(w5_, w4_, 16), x5_ = __builtin_amdgcn_alignbit(w6_, w5_, 16), x6_ = __builtin_amdgcn_alignbit(w7_, w6_, 16); \
            pg8::bf16x8 A_[8]; \
            A_[0] = __builtin_bit_cast(pg8::bf16x8, (u32x4){w4_, w5_, w6_, w7_}); A_[1] = __builtin_bit_cast(pg8::bf16x8, (u32x4){x3_, x4_, x5_, x6_}); \
            A_[2] = __builtin_bit_cast(pg8::bf16x8, (u32x4){w3_, w4_, w5_, w6_}); A_[3] = __builtin_bit_cast(pg8::bf16x8, (u32x4){x2_, x3_, x4_, x5_}); \
            A_[4] = __builtin_bit_cast(pg8::bf16x8, (u32x4){w2_, w3_, w4_, w5_}); A_[5] = __builtin_bit_cast(pg8::bf16x8, (u32x4){x1_, x2_, x3_, x4_}); \
            A_[6] = __builtin_bit_cast(pg8::bf16x8, (u32x4){w1_, w2_, w3_, w4_}); A_[7] = __builtin_bit_cast(pg8::bf16x8, (u32x4){x0_, x1_, x2_, x3_}); \
            _Pragma("unroll") for (int r = 0; r < 8; ++r) { \
                acc[r][0] = __builtin_amdgcn_mfma_f32_16x16x32_bf16(A_[r], BV[SET][0], acc[r][0], 0, 0, 0); \
                acc[r][1] = __builtin_amdgcn_mfma_f32_16x16x32_bf16(A_[r], BV[SET][1], acc[r][1], 0, 0, 0); } } while (0)
        u32x4 WL[2], WH[2]; pg8::bf16x8 BV[2][2];
        HY_LOAD(0, Dlo);
#pragma unroll 1
        for (int D = Dlo; D <= Dhi; D += 64) {
            HY_LOAD(1, D + 32);
            __builtin_amdgcn_sched_barrier(0);
            __builtin_amdgcn_s_setprio(1); HY_MMA(0); __builtin_amdgcn_s_setprio(0);
            __builtin_amdgcn_sched_barrier(0);
            HY_LOAD(0, D + 64);
            __builtin_amdgcn_sched_barrier(0);
            __builtin_amdgcn_s_setprio(1); HY_MMA(1); __builtin_amdgcn_s_setprio(0);
            __builtin_amdgcn_sched_barrier(0);
        }
#undef HY_LOAD
#undef HY_MMA
#pragma unroll
        for (int cb = 0; cb < 2; ++cb) { float* yo = yT + (size_t)c * MH + (size_t)bq * L + (cb ? tc1 : tc0) + 32 * fq;
#pragma unroll
            for (int j = 0; j < 4; ++j) { *(f32x4*)(yo + 8 * j) = (f32x4){acc[0][cb][j], acc[1][cb][j], acc[2][cb][j], acc[3][cb][j]}; *(f32x4*)(yo + 8 * j + 4) = (f32x4){acc[4][cb][j], acc[5][cb][j], acc[6][cb][j], acc[7][cb][j]}; } }
        __syncthreads();
    }
}

__device__ __forceinline__ void hg_chain_naive(const P& p, unsigned char* lds, int l, int b, int h, int dir, int L) {
    int tid_ = threadIdx.x; asm volatile("" : "+v"(tid_)); OPQ_Z const int tid = tid_, dv = tid & 127, kq = __builtin_amdgcn_readfirstlane(tid >> 7);
    const bf16_t* __restrict__ ub = (const bf16_t*)(PWS + WS_U); bf16_t* __restrict__ ob = (bf16_t*)(PWS + (dir ? WS_OB : WS_OF));
    float* fs = (float*)lds; float* ks = fs + 128; float* qs = ks + 128; float* op = qs + 128;
    const float lbv = ((const float*)(PWS + WS_LB))[(dir * 2 + l) * 512 + h * 128 + dv];
    float S[32];
#pragma unroll
    for (int i = 0; i < 32; ++i) S[i] = 0.f;
    const int zoff = (dir ? 2304 : 1792) + h * 128 + dv, qoff = 768 + h * 128 + dv, voff = 1280 + h * 128 + dv;
    size_t row = (size_t)b * L + (dir ? L - 1 : 0);
    bf16_t zn = ub[row * DIN + zoff], qn = ub[row * DIN + qoff], vn = ub[row * DIN + voff];
#pragma unroll 1
    for (int step = 0; step < L; ++step) {
        const size_t crow = row; const float z = bf2f(zn), q = bf2f(qn), v = bf2f(vn);
        if (step + 1 < L) { row = dir ? row - 1 : row + 1; zn = ub[row * DIN + zoff]; qn = ub[row * DIN + qoff]; vn = ub[row * DIN + voff]; }
        if (tid < 128) { const float sg = sigm(z); fs[tid] = lbv + (1.0f - lbv) * sg; ks[tid] = (1.0f - lbv) * (1.0f - sg); qs[tid] = q; }
        __syncthreads();
        float o = 0.f;
#pragma unroll
        for (int i = 0; i < 32; ++i) { const int k = kq * 32 + i; S[i] = fs[k] * S[i] + ks[k] * v; o += S[i] * qs[k]; }
        op[kq * 128 + dv] = o;
        __syncthreads();
        if (tid < 128) ob[crow * 512 + h * 128 + tid] = f2bf(op[tid] + op[128 + tid] + op[256 + tid] + op[384 + tid]);
    }
    __syncthreads();
}


__device__ __forceinline__ void mix_phase(const P& p, unsigned char* lds, int l, int B, int L) {
    const int G = opq_grid(), bid = blockIdx.x;
    rg_carry(p, B, L);
#ifdef HG_NAIVE
#pragma unroll 1
    for (int it = bid; it < B * 8; it += G) hg_chain_naive(p, lds, l, it >> 3, (it >> 1) & 3, it & 1, L);
#else
    { int t2_ = threadIdx.x; asm volatile("" : "+v"(t2_));
#pragma unroll 1
      for (int it = bid; it < 256; it += G) HGSEG<true>(p, lds, l, it, L, t2_);
#ifdef DUP_HG
      for (int it = bid; it < 256; it += G) HGSEG<true>(p, lds, l, it, L, t2_);
#endif
    }
#endif
#ifdef HY_NAIVE
    hy_conv_naive(p, lds, B, L);
#else
    hy_conv_mfma(p, lds, B, L);
#ifdef DUP_HY
    hy_conv_mfma(p, lds, B, L);
#endif
#endif
}

__device__ __forceinline__ void post_phase(const P& p, unsigned char* lds, int l, int B, int L) {
    int tid_ = threadIdx.x; asm volatile("" : "+v"(tid_)); OPQ_Z const int tid = tid_, lane = tid & 63, wid = tid >> 6, G = opq_grid();
    const bf16_t* __restrict__ ub = (const bf16_t*)(PWS + WS_U); const float* __restrict__ yT = (const float*)(PWS + WS_YT);
    const bf16_t* __restrict__ of = (const bf16_t*)(PWS + WS_OF); const bf16_t* __restrict__ obk = (const bf16_t*)(PWS + WS_OB);
    bf16_t* __restrict__ yb = (bf16_t*)(PWS + WS_H);
    float* sy = (float*)lds;
    const float* cw = PIN(12) + l * 3 * 768; const float* cb = PIN(13) + l * 768; const float* hbias = PIN(22) + l * 256; const float* gain = PIN(6) + l * 1024;
#pragma unroll 1
    for (int tile = blockIdx.x; tile < MH / 64; tile += G) {
        const int r0 = tile * 64, rowb = (r0 / L) * L, t0 = r0 - rowb;
#pragma unroll 4
        for (int e = tid; e < 256 * 16; e += 512) { const int c = e >> 4, t4 = (e & 15) * 4; const f32x4 yv = *(const f32x4*)(yT + (size_t)c * MH + r0 + t4);
            sy[t4 * 257 + c] = yv[0]; sy[(t4 + 1) * 257 + c] = yv[1]; sy[(t4 + 2) * 257 + c] = yv[2]; sy[(t4 + 3) * 257 + c] = yv[3]; }
        __syncthreads();
#pragma unroll 2
        for (int r = 0; r < 4; ++r) {
            const int t = 2 * (wid + 8 * r) + (lane >> 5), tok = t0 + t, c0 = (lane & 31) * 8; const size_t row = (size_t)(r0 + t);
            float cv[3][8];
#pragma unroll
            for (int g = 0; g < 3; ++g) { const f32x4 b0 = *(const f32x4*)(cb + g * 256 + c0), b1 = *(const f32x4*)(cb + g * 256 + c0 + 4);
#pragma unroll
                for (int e = 0; e < 4; ++e) { cv[g][e] = b0[e]; cv[g][4 + e] = b1[e]; } }
#pragma unroll
            for (int k2 = 0; k2 < 3; ++k2) { const int tt = tok + k2 - 1;
                if (tt >= 0 && tt < L) {
#pragma unroll
                    for (int g = 0; g < 3; ++g) { const u32x4 xa = *(const u32x4*)(ub + (row + k2 - 1) * DIN + g * 256 + c0); const float* wa = cw + k2 * 768 + g * 256 + c0;
                        const f32x4 a0 = *(const f32x4*)wa, a1 = *(const f32x4*)(wa + 4);
                        cv[g][0] += a0[0] * lo16(xa.x); cv[g][1] += a0[1] * hi16(xa.x); cv[g][2] += a0[2] * lo16(xa.y); cv[g][3] += a0[3] * hi16(xa.y);
                        cv[g][4] += a1[0] * lo16(xa.z); cv[g][5] += a1[1] * hi16(xa.z); cv[g][6] += a1[2] * lo16(xa.w); cv[g][7] += a1[3] * hi16(xa.w); } } }
            float y[8], ss = 0.f;
            { const f32x4 h0 = *(const f32x4*)(hbias + c0), h1 = *(const f32x4*)(hbias + c0 + 4);
#pragma unroll
              for (int e = 0; e < 8; ++e) { const float v = cv[2][e] * cv[1][e]; y[e] = (sy[t * 257 + c0 + e] + v * (e < 4 ? h0[e & 3] : h1[e & 3])) * cv[0][e]; ss += y[e] * y[e]; } }
            ss += __shfl_xor(ss, 16); ss += __shfl_xor(ss, 8); ss += __shfl_xor(ss, 4); ss += __shfl_xor(ss, 2); ss += __shfl_xor(ss, 1);
            const float rstd = rsqrtf(ss * (1.0f / 256.0f) + EPSN); const f32x4 g0 = *(const f32x4*)(gain + c0), g1 = *(const f32x4*)(gain + c0 + 4);
            u32x4 o; o.x = pk2(y[0] * rstd * g0[0], y[1] * rstd * g0[1]); o.y = pk2(y[2] * rstd * g0[2], y[3] * rstd * g0[3]); o.z = pk2(y[4] * rstd * g1[0], y[5] * rstd * g1[1]); o.w = pk2(y[6] * rstd * g1[2], y[7] * rstd * g1[3]);
            *(u32x4*)(yb + row * DM + c0) = o;
        }
#pragma unroll 4
        for (int r = 0; r < 8; ++r) { const int t = wid + 8 * r; const size_t row = (size_t)(r0 + t);
            { const u32x4 a = *(const u32x4*)(of + row * 512 + lane * 8), b = *(const u32x4*)(obk + row * 512 + lane * 8), gw = *(const u32x4*)(ub + row * DIN + 2816 + lane * 8);
              float o8[8] = {lo16(a.x) + lo16(b.x), hi16(a.x) + hi16(b.x), lo16(a.y) + lo16(b.y), hi16(a.y) + hi16(b.y), lo16(a.z) + lo16(b.z), hi16(a.z) + hi16(b.z), lo16(a.w) + lo16(b.w), hi16(a.w) + hi16(b.w)};
              const float g8[8] = {lo16(gw.x), hi16(gw.x), lo16(gw.y), hi16(gw.y), lo16(gw.z), hi16(gw.z), lo16(gw.w), hi16(gw.w)};
              float s2 = 0.f;
#pragma unroll
              for (int e = 0; e < 8; ++e) s2 += o8[e] * o8[e];
              s2 += __shfl_xor(s2, 1); s2 += __shfl_xor(s2, 2); s2 += __shfl_xor(s2, 4); s2 += __shfl_xor(s2, 8);
              const float rstd = rsqrtf(s2 * (1.0f / 128.0f) + EPSN); const float* gn = gain + 256 + lane * 8;
#pragma unroll
              for (int e = 0; e < 8; ++e) { const float gg = g8[e]; o8[e] = o8[e] * rstd * gn[e] * (gg * sigm(gg)); }
              u32x4 o; o.x = pk2(o8[0], o8[1]); o.y = pk2(o8[2], o8[3]); o.z = pk2(o8[4], o8[5]); o.w = pk2(o8[6], o8[7]);
              *(u32x4*)(yb + row * DM + 256 + lane * 8) = o; }
        }
        __syncthreads();
    }
    int tid2_ = threadIdx.x; asm volatile("" : "+v"(tid2_)); const int tid2 = tid2_;
    pg8::bf16x8 Bw[8][2]; RgPrm prm; RG_LOAD_W(p, l, tid2, Bw, prm);
#pragma unroll 1
    for (int tile = blockIdx.x; tile < MH / 32; tile += G) {
        const int r0 = tile * 32, rowb = (r0 / L) * L, t0 = r0 - rowb;
        rg_tile<true>(p, lds, l, rowb, L, t0, ub, yb, Bw, prm, tid2);
    }
#ifdef DUP_RGC
#pragma unroll 1
    for (int tile = blockIdx.x; tile < MH / 32; tile += G) {
        const int r0 = tile * 32, rowb = (r0 / L) * L, t0 = r0 - rowb;
        rg_tile<true>(p, lds, l, rowb, L, t0, ub, yb, Bw, prm, tid2);
    }
#endif
}

#ifdef DUP_SYNC
#define GSYNC() do { xcd_barrier(xbar); xcd_barrier(xbar); } while (0)
#else
#define GSYNC() xcd_barrier(xbar)
#endif
__global__ void __launch_bounds__(512, 2) hymba_fwd(P p) {
    extern __shared__ __attribute__((aligned(16))) unsigned char lds[];
    cg::grid_group grid = cg::this_grid();
    OPQ_Z
    if (threadIdx.x < 4) ((unsigned*)(lds + LDS_BYTES - 16))[threadIdx.x] = 0u;
    __syncthreads();
    const XcdBarrier xbar = xcd_barrier_post((unsigned*)(PWS + WS_BAR), (volatile LAS unsigned*)(lds + LDS_BYTES - 16));
    const int G = opq_grid(), bid = blockIdx.x;
    bf16_t* hbuf = (bf16_t*)(PWS + WS_H); bf16_t* ubuf = (bf16_t*)(PWS + WS_U);
    const float* mod = (const float*)(PWS + WS_MOD);
#ifndef NO_INIT
    init_phase(p, lds);
#ifdef DUP_INIT
    init_phase(p, lds);
#endif
#endif
    int oK1 = DM, oK2 = DFF, oN1 = DIN, oN2 = DM, oN3 = 2 * DFF, oM = MH;
    asm volatile("" : "+s"(oK1), "+s"(oK2), "+s"(oN1), "+s"(oN2), "+s"(oN3), "+s"(oM));
    grid.sync();
#pragma unroll 1
    for (int half = 0; half < 2; ++half) {
        const int B = half ? 2 : 8, L = half ? 16384 : 4096, lshift = half ? 14 : 12, rbase = half ? 8 : 0;
        const float* xin = PIN(half); float* xres = POUT + (size_t)half * MH * DM;
#pragma unroll 1
        for (int l = 0; l < 2; ++l) {
            const float* xcur = l == 0 ? xin : xres;
            const float* modl = mod + (size_t)l * 10 * 6144;
#ifndef NO_NORM
            norm_mod(xcur, PIN(9) + l * DM, modl, 1024, 0, rbase, lshift, hbuf);
#endif
#ifndef NO_FILT
            filter_gen(p, lds, l, L);
#ifdef DUP_FILT
            filter_gen(p, lds, l, L);
#endif
#endif
            GSYNC();
#ifndef NO_G1
            { pg8::Gemm g{hbuf, (const bf16_t*)(PWS + WS_WIN) + (size_t)l * DIN * DM, oM, oN1, oK1}; pg8::StaticOrder S; S.init(oM, oN1, G, bid); EpiB16 E{ubuf, DIN};
              pg8::gemm_phase<EpiB16, pg8::StaticOrder>((LDSP unsigned char*)lds, g, S, E, nullptr);
#ifdef DUP_G1
              pg8::gemm_phase<EpiB16, pg8::StaticOrder>((LDSP unsigned char*)lds, g, S, E, nullptr);
#endif
            }
#endif
            GSYNC();
#ifndef NO_PREP
            prep_phase(p, lds, l, B, L);
#ifdef DUP_PREP
            prep_phase(p, lds, l, B, L);
#endif
#endif
            GSYNC();
#ifndef NO_MIX
            mix_phase(p, lds, l, B, L);
#endif
            GSYNC();
#ifndef NO_POST
            post_phase(p, lds, l, B, L);
#ifdef DUP_POST
            post_phase(p, lds, l, B, L);
#endif
#endif
            GSYNC();
#ifndef NO_G2
            { pg8::Gemm g{hbuf, (const bf16_t*)(PWS + WS_WOUT) + (size_t)l * DM * DM, oM, oN2, oK1}; pg8::StaticOrder S; S.init(oM, oN2, G, bid); EpiRes E{xcur, xres, modl + (size_t)rbase * 6144 + 2048, lshift};
              pg8::gemm_phase<EpiRes, pg8::StaticOrder>((LDSP unsigned char*)lds, g, S, E, nullptr); }
#endif
            GSYNC();
            norm_mod(xres, PIN(10) + l * DM, modl, 4096, 3072, rbase, lshift, hbuf);
            GSYNC();
#ifndef NO_G3
            { pg8::Gemm g{hbuf, (const bf16_t*)(PWS + WS_WGU) + (size_t)l * 2 * DFF * DM, oM, oN3, oK1}; pg8::StaticOrder S; S.init(oM, oN3, G, bid); EpiSwi E{ubuf};
              pg8::gemm_phase<EpiSwi, pg8::StaticOrder>((LDSP unsigned char*)lds, g, S, E, nullptr);
#ifdef DUP_G3
              pg8::gemm_phase<EpiSwi, pg8::StaticOrder>((LDSP unsigned char*)lds, g, S, E, nullptr);
#endif
            }
#endif
            GSYNC();
#ifndef NO_G4
            { pg8::Gemm g{ubuf, (const bf16_t*)(PWS + WS_WD) + (size_t)l * DM * DFF, oM, oN2, oK2}; pg8::StaticOrder S; S.init(oM, oN2, G, bid); EpiRes E{xres, xres, modl + (size_t)rbase * 6144 + 5120, lshift};
              pg8::gemm_phase<EpiRes, pg8::StaticOrder>((LDSP unsigned char*)lds, g, S, E, nullptr); }
#endif
            GSYNC();
        }
        final_norm(xres, PIN(11));
    }
}

extern "C" void kernel_launch(void* const* d_in, const int* in_sizes, int n_in, void* d_out, int out_size, void* d_ws, size_t ws_size, hipStream_t stream) {
    static int grid = 0;
    if (grid == 0) {
        int dev = 0, cus = 0, per_cu = 0;
        hipGetDevice(&dev); hipDeviceGetAttribute(&cus, hipDeviceAttributeMultiprocessorCount, dev);
        hipFuncSetAttribute((const void*)hymba_fwd, hipFuncAttributeMaxDynamicSharedMemorySize, LDS_BYTES);
        hipOccupancyMaxActiveBlocksPerMultiprocessor(&per_cu, (const void*)hymba_fwd, 512, LDS_BYTES);
        if (per_cu < 1) per_cu = 1;
        grid = cus * per_cu;
        if (n_in != 34 || ws_size < WS_NEED) { fprintf(stderr, "kernel_launch: unexpected n_in %d / ws %zu\n", n_in, ws_size); }
    }
    P p{};
    for (int i = 0; i < 34; ++i) p.ptr[i] = d_in[i];
    p.ptr[34] = d_out; p.ptr[35] = d_ws;
    (void)hipMemsetAsync((unsigned char*)d_ws + WS_BAR, 0, 16384, stream);
    void* args[] = {&p};
    hipError_t e = hipLaunchCooperativeKernel((const void*)hymba_fwd, dim3(grid), dim3(512), args, LDS_BYTES, stream);
    if (e != hipSuccess) fprintf(stderr, "cooperative launch failed: %s (grid %d)\n", hipGetErrorString(e), grid);
}
```
